# Optimizing an MI355X kernel written in HIP

```python
import math
import jax, jax.numpy as jnp
from jax import lax
import numpy as np

D_MODEL = 1024
BATCH = 4
SEQ = 4096
DEPTH = 2

GRID_W = 64
CTX_LEN = 256
N_EVEN = (DEPTH + 1) // 2
N_ODD = DEPTH // 2

C_HYENA = D_MODEL // 2
C_NA = D_MODEL - C_HYENA
NA_HEAD_DIM = 32
NA_HEADS = C_NA // NA_HEAD_DIM
NA_WIN_R = 8
NA_WIN_C = 16
NA_QB = 16
NA_BAND = NA_QB + NA_WIN_C
HYENA_ORDER = 2
HYENA_SHORT = 3
HYENA_EMB = 33
HYENA_BANDS = (HYENA_EMB - 1) // 2
HYENA_FILTER_HID = 64
HYENA_FAST_DECAY = 0.3
HYENA_SLOW_DECAY = 1.5
HYENA_TARGET = 1e-2
F_GROUPS = 4
D_FF = 2816
N_EXPERTS = 8
TOP_K = 2
D_FF_EXPERT = 3584
N_MOD = 6
EPS = 1e-6
NEG_INF = -1e30

kernel_name = "hybrid_hyena_natten_fnet_moe_dit"


def rmsnorm(x, g):
    x32 = x.astype(jnp.float32)
    y = x32 * lax.rsqrt(jnp.mean(x32 * x32, axis=-1, keepdims=True) + EPS)
    return (y * g.astype(jnp.float32)).astype(x.dtype)


def modulate(h, shift, scale):
    return h * (1 + scale) + shift


def ada_params(cvec, w, b):
    return jnp.split(jax.nn.silu(cvec) @ w + b, N_MOD, axis=-1)


def swiglu(h, w1, w3, w2):
    return (jax.nn.silu(h @ w1) * (h @ w3)) @ w2


def moe_swiglu(h, w_router, b_router, w1, w3, w2):
    logits = (h @ w_router).astype(jnp.float32) + b_router.astype(jnp.float32)
    top_val, top_idx = lax.top_k(logits, TOP_K)
    top_w = jax.nn.softmax(top_val, axis=-1)
    gate = jnp.einsum('blk,blke->ble', top_w,
                      jax.nn.one_hot(top_idx, N_EXPERTS, dtype=jnp.float32)).astype(h.dtype)
    out = jnp.zeros_like(h)
    for e in range(N_EXPERTS):
        out = out + gate[..., e:e + 1] * swiglu(h, w1[e], w3[e], w2[e])
    return out


def hyena_filters(L, w1, b1, w2, b2, w3, freq):
    f32 = jnp.float32
    w1, b1, w2, b2, w3, freq = (a.astype(f32) for a in (w1, b1, w2, b2, w3, freq))
    t = jnp.linspace(0.0, 1.0, L, dtype=f32)[:, None]
    bands = jnp.linspace(1e-4, HYENA_BANDS - 1, HYENA_BANDS, dtype=f32)
    ang = (2.0 * math.pi / L) * jnp.arange(L, dtype=f32)[:, None] * bands[None, :]
    feats = jnp.concatenate([t, jnp.cos(ang), -jnp.sin(ang)], axis=-1)
    h = jnp.sin(freq[0] * (feats @ w1 + b1))
    h = jnp.sin(freq[1] * (h @ w2 + b2))
    h = (h @ w3).reshape(L, HYENA_ORDER, 2, C_HYENA)
    deltas = jnp.abs(jnp.linspace(math.log(HYENA_TARGET) / HYENA_SLOW_DECAY,
                                  math.log(HYENA_TARGET) / HYENA_FAST_DECAY, C_HYENA, dtype=f32))
    h = h * jnp.exp(-t * deltas[None, :])[:, None, None, :]
    k = jnp.concatenate([h[:, :, 0], jnp.zeros((1, HYENA_ORDER, C_HYENA), f32), h[:0:-1, :, 1]], axis=0)
    return k / (jnp.sum(jnp.abs(k), axis=0, keepdims=True) + EPS)


def long_conv(u, k, skip):
    L = u.shape[1]
    u32 = u.astype(jnp.float32)
    U = jnp.fft.rfft(u32, n=2 * L, axis=1)
    K = jnp.fft.rfft(k, axis=0)
    y = jnp.fft.irfft(U * K[None], n=2 * L, axis=1)[:, :L]
    return (y + u32 * skip.astype(jnp.float32)).astype(u.dtype)


def hyena_mixer(z, short_w, short_b, f_w1, f_b1, f_w2, f_b2, f_w3, f_freq, skip):
    L = z.shape[1]
    zp = jnp.pad(z, ((0, 0), (1, 1), (0, 0)))
    z = zp[:, :-2] * short_w[0] + zp[:, 1:-1] * short_w[1] + zp[:, 2:] * short_w[2] + short_b
    v, x1, x2 = jnp.split(z, 3, axis=-1)
    filt = hyena_filters(L, f_w1, f_b1, f_w2, f_b2, f_w3, f_freq)
    y = x1 * long_conv(v, filt[:, 0], skip[0])
    y = x2 * long_conv(y, filt[:, 1], skip[1])
    return y


def to_heads(t):
    B, L, _ = t.shape
    return t.reshape(B, L, NA_HEADS, NA_HEAD_DIM).transpose(0, 2, 1, 3)


def to_grid(t, rows):
    B = t.shape[0]
    return t.reshape(B, rows, GRID_W, NA_HEADS, NA_HEAD_DIM).transpose(0, 3, 1, 2, 4)


def context_attention(q, k, v):
    s = jnp.einsum('bhqd,bhkd->bhqk', q, k).astype(jnp.float32) * (NA_HEAD_DIM ** -0.5)
    p = jax.nn.softmax(s, axis=-1).astype(v.dtype)
    o = jnp.einsum('bhqk,bhkd->bhqd', p, v)
    B, H, L, dh = o.shape
    return o.transpose(0, 2, 1, 3).reshape(B, L, H * dh)


def neighborhood_attention(q, k, v, k_ctx, v_ctx, rpb):
    B, H, rows, W, dh = q.shape
    win_r = min(NA_WIN_R, rows)
    ncb = W // NA_QB
    scale = dh ** -0.5
    qcol = jnp.arange(W).reshape(ncb, NA_QB)
    c_start = jnp.clip(qcol - NA_WIN_C // 2, 0, W - NA_WIN_C)
    band_start = jnp.clip(jnp.arange(ncb) * NA_QB - NA_WIN_C // 2, 0, W - NA_BAND)
    band_cols = band_start[:, None] + jnp.arange(NA_BAND)
    kcol = band_cols[:, None, :]
    col_ok = (kcol >= c_start[..., None]) & (kcol < c_start[..., None] + NA_WIN_C)
    col_idx = jnp.clip(kcol - qcol[..., None] + NA_WIN_C - 1, 0, 2 * NA_WIN_C - 2)
    rpb32 = rpb.astype(jnp.float32)
    n_loc = win_r * NA_BAND

    def one_row(r):
        r0 = jnp.clip(r - win_r // 2, 0, rows - win_r)
        q_r = lax.dynamic_index_in_dim(q, r, axis=2, keepdims=False).reshape(B, H, ncb, NA_QB, dh)
        k_r = jnp.take(lax.dynamic_slice_in_dim(k, r0, win_r, axis=2), band_cols, axis=3)
        v_r = jnp.take(lax.dynamic_slice_in_dim(v, r0, win_r, axis=2), band_cols, axis=3)
        row_idx = r0 + jnp.arange(win_r) - r + NA_WIN_R - 1
        bias = rpb32[:, row_idx[None, None, :, None], col_idx[:, :, None, :]]
        s_loc = jnp.einsum('bhjqd,bhrjkd->bhjqrk', q_r, k_r).astype(jnp.float32) * scale + bias
        s_loc = jnp.where(col_ok[:, :, None, :], s_loc, NEG_INF)
        s_ctx = jnp.einsum('bhjqd,bhcd->bhjqc', q_r, k_ctx).astype(jnp.float32) * scale
        logits = jnp.concatenate([s_loc.reshape(B, H, ncb, NA_QB, n_loc), s_ctx], axis=-1)
        p = jax.nn.softmax(logits, axis=-1).astype(v.dtype)
        p_loc = p[..., :n_loc].reshape(B, H, ncb, NA_QB, win_r, NA_BAND)
        o = (jnp.einsum('bhjqrk,bhrjkd->bhjqd', p_loc, v_r)
             + jnp.einsum('bhjqc,bhcd->bhjqd', p[..., n_loc:], v_ctx))
        return o.reshape(B, H, W, dh)

    out = lax.map(one_row, jnp.arange(rows))
    return out.transpose(1, 0, 3, 2, 4).reshape(B, rows * W, H * dh)


def fourier_mix(h):
    B, L, D = h.shape
    hg = h.astype(jnp.float32).reshape(B, L, F_GROUPS, D // F_GROUPS)
    y = jnp.fft.fftn(hg, axes=(1, 3), norm='ortho').real
    return y.reshape(B, L, D).astype(h.dtype)


def setup_inputs(seed: int = 0) -> dict:
    key = jax.random.key(seed)
    ks = iter(jax.random.split(key, 32))
    f32 = jnp.float32
    D = D_MODEL

    def dense(shape, fan_in):
        return jax.random.normal(next(ks), shape, f32) * (fan_in ** -0.5)

    def small(shape, s):
        return jax.random.normal(next(ks), shape, f32) * s

    return {
        'x': small((BATCH, SEQ, D), 1.0),
        'c': small((BATCH, D), 1.0),
        'ctx': small((BATCH, CTX_LEN, D), 1.0),
        'c_ctx': small((D,), 1.0),
        'w_ada': dense((DEPTH, D, N_MOD * D), D),
        'b_ada': small((DEPTH, N_MOD * D), 0.02),
        'norm_g': 1.0 + small((DEPTH, 2, D), 0.02),
        'w_in': dense((N_EVEN, D, 3 * C_HYENA + 3 * C_NA), D),
        'hy_short_w': dense((N_EVEN, HYENA_SHORT, 3 * C_HYENA), HYENA_SHORT),
        'hy_short_b': small((N_EVEN, 3 * C_HYENA), 0.02),
        'hy_f_w1': dense((N_EVEN, HYENA_EMB, HYENA_FILTER_HID), HYENA_EMB),
        'hy_f_b1': small((N_EVEN, HYENA_FILTER_HID), 0.02),
        'hy_f_w2': dense((N_EVEN, HYENA_FILTER_HID, HYENA_FILTER_HID), HYENA_FILTER_HID),
        'hy_f_b2': small((N_EVEN, HYENA_FILTER_HID), 0.02),
        'hy_f_w3': dense((N_EVEN, HYENA_FILTER_HID, HYENA_ORDER * 2 * C_HYENA), HYENA_FILTER_HID),
        'hy_f_freq': 1.0 + small((N_EVEN, 2, HYENA_FILTER_HID), 0.02),
        'hy_skip': small((N_EVEN, HYENA_ORDER, C_HYENA), 0.5),
        'na_rpb': small((N_EVEN, NA_HEADS, 2 * NA_WIN_R - 1, 2 * NA_WIN_C - 1), 0.1),
        'w_mix_out': dense((N_EVEN, D, D), D),
        'ffn_w1': dense((N_EVEN, D, D_FF), D),
        'ffn_w3': dense((N_EVEN, D, D_FF), D),
        'ffn_w2': dense((N_EVEN, D_FF, D), D_FF),
        'w_fourier': dense((N_ODD, D, D), D),
        'w_router': dense((N_ODD, D, N_EXPERTS), D),
        'b_router': small((N_ODD, N_EXPERTS), 0.01),
        'moe_w1': dense((N_ODD, N_EXPERTS, D, D_FF_EXPERT), D),
        'moe_w3': dense((N_ODD, N_EXPERTS, D, D_FF_EXPERT), D),
        'moe_w2': dense((N_ODD, N_EXPERTS, D_FF_EXPERT, D), D_FF_EXPERT),
        'final_g': 1.0 + small((D,), 0.02),
    }


def reference(x, c, ctx, c_ctx, w_ada, b_ada, norm_g, w_in, hy_short_w, hy_short_b,
              hy_f_w1, hy_f_b1, hy_f_w2, hy_f_b2, hy_f_w3, hy_f_freq, hy_skip, na_rpb,
              w_mix_out, ffn_w1, ffn_w3, ffn_w2, w_fourier, w_router, b_router,
              moe_w1, moe_w3, moe_w2, final_g):
    rows = x.shape[1] // GRID_W
    kv_off = 3 * C_HYENA + C_NA
    xc = ctx
    for layer in range(DEPTH):
        even = layer % 2 == 0
        update_ctx = any(l % 2 == 0 for l in range(layer + 1, DEPTH))
        g_mix, g_ffn = norm_g[layer, 0], norm_g[layer, 1]
        sh1, sc1, gt1, sh2, sc2, gt2 = ada_params(c[:, None, :], w_ada[layer], b_ada[layer])
        if even or update_ctx:
            csh1, csc1, cgt1, csh2, csc2, cgt2 = ada_params(c_ctx[None, None, :], w_ada[layer], b_ada[layer])
        if even:
            i = layer // 2
            hy = (hy_short_w[i], hy_short_b[i], hy_f_w1[i], hy_f_b1[i], hy_f_w2[i], hy_f_b2[i],
                  hy_f_w3[i], hy_f_freq[i], hy_skip[i])
            h = modulate(rmsnorm(x, g_mix), sh1, sc1)
            z = h @ w_in[i]
            q, k, v = jnp.split(z[..., 3 * C_HYENA:], 3, axis=-1)
            hc = modulate(rmsnorm(xc, g_mix), csh1, csc1)
            if update_ctx:
                zc = hc @ w_in[i]
                kvc = zc[..., kv_off:]
            else:
                kvc = hc @ w_in[i][:, kv_off:]
            kc, vc = jnp.split(kvc, 2, axis=-1)
            kc, vc = to_heads(kc), to_heads(vc)
            y_na = neighborhood_attention(to_grid(q, rows), to_grid(k, rows), to_grid(v, rows), kc, vc, na_rpb[i])
            y_hy = hyena_mixer(z[..., :3 * C_HYENA], *hy)
            x = x + gt1 * (jnp.concatenate([y_hy, y_na], axis=-1) @ w_mix_out[i])
            if update_ctx:
                yc_na = context_attention(to_heads(zc[..., 3 * C_HYENA:kv_off]), kc, vc)
                yc_hy = hyena_mixer(zc[..., :3 * C_HYENA], *hy)
                xc = xc + cgt1 * (jnp.concatenate([yc_hy, yc_na], axis=-1) @ w_mix_out[i])
            x = x + gt2 * swiglu(modulate(rmsnorm(x, g_ffn), sh2, sc2), ffn_w1[i], ffn_w3[i], ffn_w2[i])
            if update_ctx:
                xc = xc + cgt2 * swiglu(modulate(rmsnorm(xc, g_ffn), csh2, csc2), ffn_w1[i], ffn_w3[i], ffn_w2[i])
        else:
            j = layer // 2
            x = x + gt1 * (fourier_mix(modulate(rmsnorm(x, g_mix), sh1, sc1)) @ w_fourier[j])
            x = x + gt2 * moe_swiglu(modulate(rmsnorm(x, g_ffn), sh2, sc2), w_router[j], b_router[j],
                                     moe_w1[j], moe_w3[j], moe_w2[j])
            if update_ctx:
                xc = xc + cgt1 * (fourier_mix(modulate(rmsnorm(xc, g_mix), csh1, csc1)) @ w_fourier[j])
                xc = xc + cgt2 * moe_swiglu(modulate(rmsnorm(xc, g_ffn), csh2, csc2), w_router[j], b_router[j],
                                            moe_w1[j], moe_w3[j], moe_w2[j])
    return rmsnorm(x, final_g)
```

```cpp
#include <hip/hip_runtime.h>
#include <cstdio>
#include <cstdint>

#ifndef MK_PER_PHASE
#define MK_PER_PHASE 0
#endif

#define LAS __attribute__((address_space(3)))
typedef unsigned short bf16;
typedef short bf16x8 __attribute__((ext_vector_type(8)));
typedef float f32x4 __attribute__((ext_vector_type(4)));
typedef float f32x2 __attribute__((ext_vector_type(2)));
typedef unsigned u32x4 __attribute__((ext_vector_type(4)));
typedef unsigned u32x2 __attribute__((ext_vector_type(2)));

#define XB_TMO      128
#define XB_XCNT(j)  (256  + 64 * (j))
#define XB_XSUB(j)  (1280 + 64 * (j))
#define XB_XGEN(j)  (2304 + 64 * (j))
#define XB_TOP      3328
#define XB_TOPGEN   3392
#define XCD_BAR_WORDS 3456
#define XB_SPIN_CAP (1u << 18)

__device__ __forceinline__ unsigned xb_ld(unsigned* p)              { return __hip_atomic_load(p, __ATOMIC_RELAXED, __HIP_MEMORY_SCOPE_AGENT); }
__device__ __forceinline__ unsigned xb_add(unsigned* p, unsigned v) { return __hip_atomic_fetch_add(p, v, __ATOMIC_RELAXED, __HIP_MEMORY_SCOPE_AGENT); }
__device__ __forceinline__ unsigned xb_xcc_id() { return (unsigned)__builtin_amdgcn_s_getreg((3 << 11) | 20) & 0xFu; }
#define XB_SPIN(cond, bar) do { unsigned _sp = 0; while (cond) { __builtin_amdgcn_s_sleep(1); \
    if ((++_sp & 255u) == 0u) { if (xb_ld(&(bar)[XB_TMO])) break; if (_sp > XB_SPIN_CAP) { atomicAdd(&(bar)[XB_TMO], 1u); break; } } } } while (0)

struct XcdBarrier { unsigned* bar; unsigned x; volatile LAS unsigned* st; };

__device__ __forceinline__ XcdBarrier xcd_barrier_post(unsigned* bar, volatile LAS unsigned* st) {
    XcdBarrier b; b.bar = bar; b.x = xb_xcc_id(); b.st = st;
    if (threadIdx.x == 0) (void)xb_add(&bar[XB_XCNT(b.x)], 1u);
    return b;
}
__device__ __forceinline__ void xcd_barrier_complete(unsigned* bar, unsigned x, unsigned& nloc, unsigned& nx) {
    const unsigned G = gridDim.x * gridDim.y * gridDim.z;
    unsigned sum, cnt, mine, sp = 0u;
    for (;;) {
        sum = 0u; cnt = 0u; mine = 0u;
#pragma unroll
        for (unsigned j = 0; j < 16; ++j) { const unsigned c = xb_ld(&bar[XB_XCNT(j)]); sum += c; cnt += (c > 0u) ? 1u : 0u; mine = (j == x) ? c : mine; }
        if (sum == G) break;
        __builtin_amdgcn_s_sleep(1);
        if ((++sp & 255u) == 0u) { if (xb_ld(&bar[XB_TMO])) break; if (sp > XB_SPIN_CAP) { atomicAdd(&bar[XB_TMO], 1u); break; } }
    }
    nloc = mine > 0u ? mine : 1u; nx = cnt > 0u ? cnt : 1u;
}
__device__ __forceinline__ void xcd_barrier(const XcdBarrier& b) {
    asm volatile("s_waitcnt vmcnt(0)" ::: "memory");
    __syncthreads();
    if (threadIdx.x == 0) {
        unsigned* bar = b.bar;
        __builtin_amdgcn_s_waitcnt(0);
        unsigned nloc = b.st[0], nx = b.st[1];
        if (nloc == 0u) { xcd_barrier_complete(bar, b.x, nloc, nx); b.st[0] = nloc; b.st[1] = nx; }
        const unsigned old = xb_add(&bar[XB_XSUB(b.x)], 1u);
        const unsigned gen = old / nloc;
        if (old + 1u == (gen + 1u) * nloc) {
            __builtin_amdgcn_fence(__ATOMIC_RELEASE, "agent");
            asm volatile("s_waitcnt vmcnt(0)" ::: "memory");
            const unsigned og = xb_add(&bar[XB_TOP], 1u);
            const unsigned tg = og / nx;
            if (og + 1u == (tg + 1u) * nx) xb_add(&bar[XB_TOPGEN], 1u);
            else XB_SPIN(xb_ld(&bar[XB_TOPGEN]) == tg, bar);
            __builtin_amdgcn_fence(__ATOMIC_ACQUIRE, "agent");
            xb_add(&bar[XB_XGEN(b.x)], 1u);
            asm volatile("s_waitcnt vmcnt(0)" ::: "memory");
        } else {
            XB_SPIN(xb_ld(&bar[XB_XGEN(b.x)]) == gen, bar);
            __builtin_amdgcn_fence(__ATOMIC_ACQUIRE, "agent");
            asm volatile("s_waitcnt vmcnt(0)" ::: "memory");
        }
    }
    __syncthreads();
}

namespace pg8 {
constexpr int BM = 256, BK = 64, HALF = 128, HTB = HALF * BK * 2, STAGE_BYTES = 8 * HTB, NXCD = 8, WGM = 8;
__host__ __device__ __forceinline__ int lds_byte(int r, int c) { const int st = (r >> 4) * 2 + (c >> 5), rr = r & 15, cc = c & 31, ob = rr * 64 + cc * 2; return st * 1024 + (ob ^ (((ob >> 9) & 1) << 5)); }
__host__ __device__ __forceinline__ void stage_rc(int b, int& R, int& C) { const int st = b / 1024, sb = b % 1024, swz = sb ^ (((sb >> 9) & 1) << 5); R = (st >> 1) * 16 + swz / 64; C = (st & 1) * 32 + (swz % 64) / 2; }
__host__ __device__ __forceinline__ int perm32(int rho) { const int n = rho >> 4, i = rho & 15; return 8 * (i >> 2) + 4 * n + (i & 3); }

struct Unit { const char* a; const char* b; char* o; int ldc; int row0; int col0; int aux; };
struct Gemm { int lda, ldb, K; };

__device__ __forceinline__ void grid_unit(int L, int nM, int nN, int& pm, int& pn) {
    const int nwg = nM * nN; int wgid = L;
    { const int q = nwg / NXCD, r = nwg % NXCD, xcd = wgid % NXCD, off = wgid / NXCD; wgid = (xcd < r ? xcd * (q + 1) : r * (q + 1) + (xcd - r) * q) + off; }
    const int nig = WGM * nN, gid = wgid / nig, fm = gid * WGM, gsz = (nM - fm) < WGM ? (nM - fm) : WGM;
    pm = fm + ((wgid % nig) % gsz); pn = (wgid % nig) / gsz;
}

__device__ __forceinline__ unsigned cvt_pk_bf16(float lo, float hi) { unsigned r; asm volatile("v_cvt_pk_bf16_f32 %0, %1, %2" : "=v"(r) : "v"(lo), "v"(hi)); return r; }

struct EpiBf16 {
    static constexpr bool PERM = true, FP8 = false;
    float scale;
    __device__ __forceinline__ void operator()(const f32x4 (&acc)[2][2][4][2], const Unit& u, int wr, int wc, int fr, int fq) const {
        bf16* base = (bf16*)u.o + (size_t)(wr * 64 + fr) * u.ldc + wc * 32 + 8 * fq;
#pragma unroll
        for (int ai = 0; ai < 2; ++ai)
#pragma unroll
            for (int m = 0; m < 4; ++m) { bf16* rowp = base + (size_t)(ai * HALF + m * 16) * u.ldc;
#pragma unroll
                for (int bj = 0; bj < 2; ++bj) { const f32x4 v0 = acc[ai][bj][m][0] * scale, v1 = acc[ai][bj][m][1] * scale;
                    u32x4 w; w.x = cvt_pk_bf16(v0[0], v0[1]); w.y = cvt_pk_bf16(v0[2], v0[3]); w.z = cvt_pk_bf16(v1[0], v1[1]); w.w = cvt_pk_bf16(v1[2], v1[3]);
                    *(u32x4*)(rowp + bj * HALF) = w; } }
    }
};
struct EpiSwiGLU {
    static constexpr bool PERM = true, FP8 = false;
    __device__ __forceinline__ void operator()(const f32x4 (&acc)[2][2][4][2], const Unit& u, int wr, int wc, int fr, int fq) const {
        bf16* base = (bf16*)u.o + (size_t)(wr * 64 + fr) * u.ldc + wc * 32 + 8 * fq;
#pragma unroll
        for (int ai = 0; ai < 2; ++ai)
#pragma unroll
            for (int m = 0; m < 4; ++m) { bf16* rowp = base + (size_t)(ai * HALF + m * 16) * u.ldc;
                float r[8];
#pragma unroll
                for (int n = 0; n < 2; ++n)
#pragma unroll
                    for (int j = 0; j < 4; j += 2) {
                        const f32x2 A = (f32x2){acc[ai][0][m][n][j], acc[ai][0][m][n][j + 1]}, B = (f32x2){acc[ai][1][m][n][j], acc[ai][1][m][n][j + 1]};
                        const f32x2 t = A * (-1.4426950408889634f); f32x2 d; d.x = __builtin_amdgcn_exp2f(t.x); d.y = __builtin_amdgcn_exp2f(t.y); d = d + 1.0f;
                        f32x2 q; q.x = __builtin_amdgcn_rcpf(d.x); q.y = __builtin_amdgcn_rcpf(d.y);
                        const f32x2 o = (A * B) * q; r[n * 4 + j] = o.x; r[n * 4 + j + 1] = o.y; }
                u32x4 w; w.x = cvt_pk_bf16(r[0], r[1]); w.y = cvt_pk_bf16(r[2], r[3]); w.z = cvt_pk_bf16(r[4], r[5]); w.w = cvt_pk_bf16(r[6], r[7]);
                *(u32x4*)rowp = w; }
    }
};
struct EpiResid {
    static constexpr bool PERM = false, FP8 = false;
    const float* R; float* X; const float* gate;
    int gstride;
    __device__ __forceinline__ void operator()(const f32x4 (&acc)[2][2][4][2], const Unit& u, int wr, int wc, int fr, int fq) const {
        const int row0 = u.row0 + wr * 64 + fr, col0 = u.col0 + wc * 32 + 4 * fq;
        const float* gp = gate + (size_t)(u.row0 >> 12) * gstride + col0;
        f32x4 gv[2][2];
#pragma unroll
        for (int bj = 0; bj < 2; ++bj)
#pragma unroll
            for (int n = 0; n < 2; ++n) gv[bj][n] = *(const f32x4*)(gp + bj * HALF + n * 16);
#pragma unroll
        for (int ai = 0; ai < 2; ++ai)
#pragma unroll
            for (int m = 0; m < 4; ++m) { const size_t ro = (size_t)(row0 + ai * HALF + m * 16) * 1024 + col0;
#pragma unroll
                for (int bj = 0; bj < 2; ++bj)
#pragma unroll
                    for (int n = 0; n < 2; ++n) { const f32x4 rv = *(const f32x4*)(R + ro + bj * HALF + n * 16); *(f32x4*)(X + ro + bj * HALF + n * 16) = rv + gv[bj][n] * acc[ai][bj][m][n]; } }
    }
};

typedef int v8i __attribute__((ext_vector_type(8)));
__device__ __forceinline__ unsigned pk4_fp8(float a, float b, float c, float d) { unsigned w = 0u; w = __builtin_amdgcn_cvt_pk_fp8_f32(a, b, w, false); w = __builtin_amdgcn_cvt_pk_fp8_f32(c, d, w, true); return w; }
struct EpiBf16F8 {
    static constexpr bool PERM = true, FP8 = true;
    float scale;
    __device__ __forceinline__ void operator()(const f32x4 (&acc)[2][2][4][2], const Unit& u, int wr, int wc, int fr, int fq) const { EpiBf16 E{scale}; E(acc, u, wr, wc, fr, fq); }
};
struct EpiSwiGLU8 {
    static constexpr bool PERM = true, FP8 = true;
    float sin, sout;
    __device__ __forceinline__ void operator()(const f32x4 (&acc)[2][2][4][2], const Unit& u, int wr, int wc, int fr, int fq) const {
        const size_t pitch = (size_t)u.ldc * 2;
        unsigned char* base = (unsigned char*)u.o + (size_t)(wr * 64 + fr) * pitch + wc * 32 + 8 * fq;
#pragma unroll
        for (int ai = 0; ai < 2; ++ai)
#pragma unroll
            for (int m = 0; m < 4; ++m) { unsigned char* rowp = base + (size_t)(ai * HALF + m * 16) * pitch;
                float r[8];
#pragma unroll
                for (int n = 0; n < 2; ++n)
#pragma unroll
                    for (int j = 0; j < 4; j += 2) {
                        const f32x2 A = (f32x2){acc[ai][0][m][n][j], acc[ai][0][m][n][j + 1]}, B = (f32x2){acc[ai][1][m][n][j], acc[ai][1][m][n][j + 1]};
                        const f32x2 t = A * (-1.4426950408889634f * sin); f32x2 d; d.x = __builtin_amdgcn_exp2f(t.x); d.y = __builtin_amdgcn_exp2f(t.y); d = d + 1.0f;
                        f32x2 q; q.x = __builtin_amdgcn_rcpf(d.x); q.y = __builtin_amdgcn_rcpf(d.y);
                        const f32x2 o = (A * B) * (sin * sin * sout) * q; r[n * 4 + j] = o.x; r[n * 4 + j + 1] = o.y; }
                u32x2 w; w.x = pk4_fp8(r[0], r[1], r[2], r[3]); w.y = pk4_fp8(r[4], r[5], r[6], r[7]);
                *(u32x2*)rowp = w; }
    }
};

template <class Epi, class Sched, bool ALIGN_EPI = true, bool SP2 = true>
__device__ __forceinline__ void gemm_phase(LAS unsigned char* lds, const Gemm g, const Sched& S, const Epi& E) {
    const int tid = threadIdx.x, wid = __builtin_amdgcn_readfirstlane(tid >> 6), lane = tid & 63, wr = wid >> 2, wc = wid & 3, fr = lane & 15, fq = lane >> 4;
    int K = g.K; asm volatile("" : "+s"(K));
    const int nt = K / BK;
    unsigned voffA[2], voffB[2];
#pragma unroll
    for (int i = 0; i < 2; ++i) { int R, C; stage_rc(tid * 16 + i * 8192, R, C); const int Rb = Epi::PERM ? ((R & ~31) + perm32(R & 31)) : R;
        voffA[i] = (unsigned)(R * g.lda + C) * 2u; voffB[i] = (unsigned)(Rb * g.ldb + C) * 2u; }
    const size_t kstep = (size_t)(BK * 2);
    const size_t hstepA = (size_t)HALF * g.lda * 2, hstepB = (size_t)HALF * g.ldb * 2;
    const unsigned ldsw = (unsigned)wid * 1024u;
    const int aoff = lds_byte(wr * 64 + fr, fq * 8), boff = lds_byte(wc * 32 + fr, fq * 8);
#define PG8_SA(b, h) (((b) * 2 + (h)) * HTB)
#define PG8_SB(b, h) ((4 + (b) * 2 + (h)) * HTB)
#define PG8_STAGE(bufoff, gbase, voff) do { _Pragma("unroll") for (int _i = 0; _i < 2; ++_i) \
        __builtin_amdgcn_global_load_lds((const unsigned*)((const char*)(gbase) + (voff)[_i]), (LAS unsigned*)(lds + (bufoff) + ldsw + _i * 8192), 16, 0, 0); } while (0)
#define PG8_LDA(dst, b, h) do { _Pragma("unroll") for (int m = 0; m < 4; ++m) _Pragma("unroll") for (int k = 0; k < 2; ++k) dst.f16[m][k] = *(const LAS bf16x8*)(lds + PG8_SA(b, h) + aoff + m * 2048 + k * 1024); } while (0)
#define PG8_LDB(dst, b, h) do { _Pragma("unroll") for (int n = 0; n < 2; ++n) _Pragma("unroll") for (int k = 0; k < 2; ++k) dst.f16[n][k] = *(const LAS bf16x8*)(lds + PG8_SB(b, h) + boff + n * 2048 + k * 1024); } while (0)
#define PG8_MMA(ai, bj, At, Bt) do { __builtin_amdgcn_s_setprio(1); _Pragma("unroll") for (int m = 0; m < 4; ++m) _Pragma("unroll") for (int n = 0; n < 2; ++n) { \
        if constexpr (Epi::FP8) asm volatile("v_mfma_f32_16x16x128_f8f6f4 %0, %1, %2, %0" : "+v"(acc[ai][bj][m][n]) : "v"(Bt.v[n]), "v"(At.v[m]));     \
        else { _Pragma("unroll") for (int k = 0; k < 2; ++k) acc[ai][bj][m][n] = __builtin_amdgcn_mfma_f32_16x16x32_bf16(Bt.f16[n][k], At.f16[m][k], acc[ai][bj][m][n], 0, 0, 0); } } \
        __builtin_amdgcn_s_setprio(0); } while (0)
#define PG8_WAIT_V(n) asm volatile("s_waitcnt vmcnt(" #n ")" ::: "memory")
#define PG8_WAIT_L(n) asm volatile("s_waitcnt lgkmcnt(" #n ")" ::: "memory")
#define PG8_BAR __builtin_amdgcn_s_barrier()
#define PG8_SCHED __builtin_amdgcn_sched_barrier(0)
    Unit cur, nxt; int ui = 0;
    if (!S.next(0, cur)) return;
    f32x4 acc[2][2][4][2];
#pragma unroll
    for (int a = 0; a < 2; ++a)
#pragma unroll
        for (int b = 0; b < 2; ++b)
#pragma unroll
            for (int m = 0; m < 4; ++m)
#pragma unroll
                for (int n = 0; n < 2; ++n) acc[a][b][m][n] = (f32x4){0.f, 0.f, 0.f, 0.f};
    union { bf16x8 f16[4][2]; v8i v[4]; } At;
    union { bf16x8 f16[2][2]; v8i v[2]; } B0, B1;
    const char* cA = cur.a; const char* cB = cur.b;
    if constexpr (SP2) {
        PG8_STAGE(PG8_SB(0, 0), cB, voffB); PG8_STAGE(PG8_SB(0, 1), cB + hstepB, voffB); PG8_STAGE(PG8_SA(0, 0), cA, voffA); PG8_STAGE(PG8_SA(0, 1), cA + hstepA, voffA);
        if (wr == 1) PG8_BAR;
        PG8_WAIT_V(2); PG8_BAR;
        PG8_STAGE(PG8_SB(1, 0), cB + kstep, voffB); PG8_STAGE(PG8_SA(1, 0), cA + kstep, voffA); PG8_STAGE(PG8_SB(1, 1), cB + hstepB + kstep, voffB);
        PG8_WAIT_V(6); PG8_BAR;
    } else {
        PG8_STAGE(PG8_SB(0, 0), cB, voffB); PG8_STAGE(PG8_SA(0, 0), cA, voffA); PG8_STAGE(PG8_SB(0, 1), cB + hstepB, voffB); PG8_STAGE(PG8_SA(0, 1), cA + hstepA, voffA);
        if (wr == 1) PG8_BAR;
        PG8_WAIT_V(4); PG8_BAR;
        PG8_STAGE(PG8_SB(1, 0), cB + kstep, voffB); PG8_STAGE(PG8_SA(1, 0), cA + kstep, voffA); PG8_STAGE(PG8_SB(1, 1), cB + hstepB + kstep, voffB);
        PG8_WAIT_V(6); PG8_BAR;
    }
    for (;;) {
        const bool has_next = S.next(ui + 1, nxt);
        const char* nA = has_next ? nxt.a : cA; const char* nB = has_next ? nxt.b : cB;
        for (int t = 0; t < nt; t += 2) {
            const bool last = (t == nt - 2);
            const char* a1 = cA + (size_t)(t + 1) * kstep;
            const char* a2 = last ? nA : cA + (size_t)(t + 2) * kstep; const char* b2 = last ? nB : cB + (size_t)(t + 2) * kstep;
            const char* a3 = a2 + kstep; const char* b3 = b2 + kstep;
            if constexpr (SP2) {
            PG8_LDB(B0, 0, 0); PG8_LDB(B1, 0, 1); PG8_SCHED; PG8_LDA(At, 0, 0); PG8_STAGE(PG8_SA(1, 1), a1 + hstepA, voffA);
            PG8_WAIT_V(8); PG8_WAIT_L(0); PG8_BAR; PG8_MMA(0, 0, At, B0); PG8_MMA(0, 1, At, B1); PG8_BAR; PG8_SCHED;
            PG8_LDA(At, 0, 1); PG8_STAGE(PG8_SB(0, 0), b2, voffB); PG8_STAGE(PG8_SB(0, 1), b2 + hstepB, voffB); PG8_STAGE(PG8_SA(0, 0), a2, voffA);
            PG8_WAIT_V(8); PG8_WAIT_L(0); PG8_BAR; PG8_MMA(1, 0, At, B0); PG8_MMA(1, 1, At, B1); PG8_BAR; PG8_SCHED;
            PG8_LDB(B0, 1, 0); PG8_LDB(B1, 1, 1); PG8_SCHED; PG8_LDA(At, 1, 0); PG8_STAGE(PG8_SA(0, 1), a2 + hstepA, voffA);
            PG8_WAIT_V(8); PG8_WAIT_L(0); PG8_BAR; PG8_MMA(0, 0, At, B0); PG8_MMA(0, 1, At, B1); PG8_BAR; PG8_SCHED;
            PG8_LDA(At, 1, 1); PG8_STAGE(PG8_SB(1, 0), b3, voffB); PG8_STAGE(PG8_SB(1, 1), b3 + hstepB, voffB); PG8_STAGE(PG8_SA(1, 0), a3, voffA);
            PG8_WAIT_V(8); PG8_WAIT_L(0); PG8_BAR; PG8_MMA(1, 0, At, B0); PG8_MMA(1, 1, At, B1); PG8_BAR; PG8_SCHED;
            } else {
            PG8_LDB(B0, 0, 0); PG8_SCHED; PG8_LDA(At, 0, 0); PG8_STAGE(PG8_SA(1, 1), a1 + hstepA, voffA);
            PG8_WAIT_L(8); PG8_BAR; PG8_WAIT_L(0); PG8_MMA(0, 0, At, B0); PG8_BAR; PG8_SCHED;
            PG8_LDB(B1, 0, 1); PG8_STAGE(PG8_SB(0, 0), b2, voffB);
            PG8_BAR; PG8_WAIT_L(0); PG8_MMA(0, 1, At, B1); PG8_BAR;
            PG8_LDA(At, 0, 1); PG8_STAGE(PG8_SA(0, 0), a2, voffA);
            PG8_BAR; PG8_WAIT_L(0); PG8_MMA(1, 0, At, B0); PG8_BAR; PG8_SCHED;
            PG8_STAGE(PG8_SB(0, 1), b2 + hstepB, voffB);
            PG8_WAIT_V(6); PG8_BAR; PG8_MMA(1, 1, At, B1); PG8_BAR;
            PG8_LDB(B0, 1, 0); PG8_SCHED; PG8_LDA(At, 1, 0); PG8_STAGE(PG8_SA(0, 1), a2 + hstepA, voffA);
            PG8_WAIT_L(8); PG8_BAR; PG8_WAIT_L(0); PG8_MMA(0, 0, At, B0); PG8_BAR; PG8_SCHED;
            PG8_LDB(B1, 1, 1); PG8_STAGE(PG8_SB(1, 0), b3, voffB);
            PG8_BAR; PG8_WAIT_L(0); PG8_MMA(0, 1, At, B1); PG8_BAR;
            PG8_LDA(At, 1, 1); PG8_STAGE(PG8_SA(1, 0), a3, voffA);
            PG8_BAR; PG8_WAIT_L(0); PG8_MMA(1, 0, At, B0); PG8_BAR; PG8_SCHED;
            PG8_STAGE(PG8_SB(1, 1), b3 + hstepB, voffB);
            PG8_WAIT_V(6); PG8_BAR; PG8_MMA(1, 1, At, B1); PG8_BAR;
            }
        }
        if constexpr (ALIGN_EPI) { if (wr == 0) PG8_BAR; }
        if constexpr (Epi::FP8) asm volatile("s_nop 15\n\ts_nop 15" ::: "memory");
        E(acc, cur, wr, wc, fr, fq);
        if (!has_next) break;
#pragma unroll
        for (int a = 0; a < 2; ++a)
#pragma unroll
            for (int b = 0; b < 2; ++b)
#pragma unroll
                for (int m = 0; m < 4; ++m)
#pragma unroll
                    for (int n = 0; n < 2; ++n) acc[a][b][m][n] = (f32x4){0.f, 0.f, 0.f, 0.f};
        cur = nxt; cA = nA; cB = nB; ++ui;
        if constexpr (ALIGN_EPI) { if (wr == 1) PG8_BAR; }
    }
    PG8_WAIT_V(0);
    if constexpr (!ALIGN_EPI) { if (wr == 0) PG8_BAR; }
    PG8_BAR;
#undef PG8_SA
#undef PG8_SB
#undef PG8_STAGE
#undef PG8_LDA
#undef PG8_LDB
#undef PG8_MMA
#undef PG8_WAIT_V
#undef PG8_WAIT_L
#undef PG8_BAR
#undef PG8_SCHED
}
}

constexpr int NWAVES = 8, NTHR = 512;
constexpr int D = 1024, NB = 4, SEQ = 4096, NT = NB * SEQ, CTX = 256, NCTX = NB * CTX;
constexpr int CH = 512;
constexpr int NH = 16, DH = 32;
constexpr int NZ = 3072, DFF = 2816, NE = 8, DFE = 3584, NMOD = 6 * D;
constexpr int CAPROWS = 2 * NT + NE * 256;
constexpr float EPS = 1e-6f;

constexpr size_t MiB = 1u << 20;
constexpr size_t WS_CTL = 0, CTL_ZERO_BYTES = 1 * MiB;
constexpr size_t WS_MOD = 1 * MiB;
constexpr size_t WS_ROUTE = 1 * MiB + 512 * 1024;
constexpr size_t WS_SHW = 1 * MiB + 256 * 1024;
constexpr size_t WS_DSH = 1 * MiB + 384 * 1024;
constexpr size_t WS_RB = 59 * MiB;
constexpr size_t WS_DFTCH = 2 * MiB;
constexpr size_t WS_MOEUP = 3 * MiB;
constexpr size_t WS_MOEDN = 115 * MiB;
constexpr size_t WS_ACOMP = 171 * MiB;
constexpr size_t WS_MACT = 239 * MiB;
constexpr size_t WS_ACS = 358 * MiB;
constexpr size_t WS_END = 486 * MiB;
constexpr size_t WS_WIN = 171 * MiB, WS_WMIX = 177 * MiB, WS_WUP = 179 * MiB, WS_WDN = 190 * MiB, WS_WFOU = 196 * MiB;
constexpr size_t WS_KT = 198 * MiB;
constexpr size_t WS_Y = 198 * MiB;
constexpr size_t WS_H = 230 * MiB, WS_HC = 262 * MiB;
constexpr size_t WS_QK = 264 * MiB, WS_VT = 296 * MiB, WS_HYT = 312 * MiB, WS_KC = 360 * MiB, WS_VCT = 361 * MiB, WS_YCAT = 362 * MiB;
constexpr size_t WS_ACT = 264 * MiB;
constexpr size_t WS_DFTSEQ = 264 * MiB, WS_PQT = 328 * MiB;
constexpr size_t WS_H2 = 400 * MiB;
constexpr size_t WS_YT = 432 * MiB;
static_assert(WS_MACT + (size_t)CAPROWS * DFE <= WS_ACS && WS_ACOMP + (size_t)CAPROWS * D * 2 <= WS_MACT && WS_ACS + (size_t)NE * NT * D <= WS_END, "ws map");
constexpr int CW_BAR = 4096;
constexpr int CW_CNT = 16384;
constexpr int CW_SS = 65536;

constexpr int RING_BYTES = 131072;
constexpr int LDS_BYTES = 163840;
constexpr int MISC_OFF = LDS_BYTES - 256;

#define LDS_WAIT() asm volatile("s_waitcnt lgkmcnt(0)" ::: "memory")
#define VM_WAIT() asm volatile("s_waitcnt vmcnt(0)" ::: "memory")
__device__ __forceinline__ unsigned pk2(float lo, float hi) { return pg8::cvt_pk_bf16(lo, hi); }
__device__ __forceinline__ float bf2f(unsigned short v) { return __uint_as_float((unsigned)v << 16); }
template <int CTRL> __device__ __forceinline__ float dpp_mov(float v) { return __int_as_float(__builtin_amdgcn_update_dpp(0, __float_as_int(v), CTRL, 0xf, 0xf, false)); }
__device__ __forceinline__ float wave_sum(float v) {
    v += dpp_mov<0xB1>(v);
    v += dpp_mov<0x4E>(v);
    v += dpp_mov<0x141>(v);
    v += dpp_mov<0x140>(v);
    const int vi = __float_as_int(v);
    return (__int_as_float(__builtin_amdgcn_readlane(vi, 0)) + __int_as_float(__builtin_amdgcn_readlane(vi, 16))) + (__int_as_float(__builtin_amdgcn_readlane(vi, 32)) + __int_as_float(__builtin_amdgcn_readlane(vi, 48)));
}

struct Frame {
    LAS unsigned char* lds;
    int tid, lane, wave, G, bid;
    const float* const* in;
    float* out;
    unsigned char* ws;
};

typedef unsigned long long u64;
constexpr float SS_SCALE = 1048576.0f;
__device__ __forceinline__ float ld_ss(const u64* p) { return (float)__hip_atomic_load(p, __ATOMIC_RELAXED, __HIP_MEMORY_SCOPE_AGENT) * (1.0f / SS_SCALE); }
__device__ __forceinline__ u32x4 pk8(const f32x4 a, const f32x4 b) { u32x4 w; w.x = pk2(a.x, a.y); w.y = pk2(a.z, a.w); w.z = pk2(b.x, b.y); w.w = pk2(b.z, b.w); return w; }
template <bool RF32, bool NORM>
struct EpiResN {
    static constexpr bool PERM = true, FP8 = false;
    const float* Rf; const bf16* Rb; bf16* XB; bf16* H; const float* gate; const float* g; const float* sc; u64* SS;
    __device__ __forceinline__ void operator()(const f32x4 (&acc)[2][2][4][2], const pg8::Unit& u, int wr, int wc, int fr, int fq) const {
        const int b = u.row0 >> 12, row0 = u.row0 + wr * 64 + fr, colb = u.col0 + wc * 32 + 8 * fq;
        f32x4 gv[2][2], gsv[2][2];
#pragma unroll
        for (int bj = 0; bj < 2; ++bj)
#pragma unroll
            for (int n = 0; n < 2; ++n) { const int c = colb + bj * pg8::HALF + 4 * n; gv[bj][n] = *(const f32x4*)(gate + (size_t)b * NMOD + c);
                if constexpr (NORM) gsv[bj][n] = *(const f32x4*)(g + c) * (*(const f32x4*)(sc + (size_t)b * NMOD + c) + 1.0f); }
#pragma unroll
        for (int ai = 0; ai < 2; ++ai)
#pragma unroll
            for (int m = 0; m < 4; ++m) { const int row = row0 + ai * pg8::HALF + m * 16; const size_t ro = (size_t)row * 1024 + colb; float ss = 0.f;
#pragma unroll
                for (int bj = 0; bj < 2; ++bj) { f32x4 r0, r1;
                    if constexpr (RF32) { r0 = *(const f32x4*)(Rf + ro + bj * pg8::HALF); r1 = *(const f32x4*)(Rf + ro + bj * pg8::HALF + 4); }
                    else { const u32x4 q = *(const u32x4*)(Rb + ro + bj * pg8::HALF);
                        r0 = (f32x4){__uint_as_float(q.x << 16), __uint_as_float(q.x & 0xffff0000u), __uint_as_float(q.y << 16), __uint_as_float(q.y & 0xffff0000u)};
                        r1 = (f32x4){__uint_as_float(q.z << 16), __uint_as_float(q.z & 0xffff0000u), __uint_as_float(q.w << 16), __uint_as_float(q.w & 0xffff0000u)}; }
                    const f32x4 x0 = r0 + gv[bj][0] * acc[ai][bj][m][0], x1 = r1 + gv[bj][1] * acc[ai][bj][m][1];
                    *(u32x4*)(XB + ro + bj * pg8::HALF) = pk8(x0, x1);
                    if constexpr (NORM) { *(u32x4*)(H + ro + bj * pg8::HALF) = pk8(x0 * gsv[bj][0], x1 * gsv[bj][1]);
                        ss += ((x0.x * x0.x + x0.y * x0.y) + (x0.z * x0.z + x0.w * x0.w)) + ((x1.x * x1.x + x1.y * x1.y) + (x1.z * x1.z + x1.w * x1.w)); } }
                if constexpr (NORM) { ss += __shfl_xor(ss, 16); ss += __shfl_xor(ss, 32);
                    if (fq == 0) (void)__hip_atomic_fetch_add(SS + row, (u64)(ss * SS_SCALE), __ATOMIC_RELAXED, __HIP_MEMORY_SCOPE_AGENT); } }
    }
};
struct EpiSwiGLUN {
    static constexpr bool PERM = true, FP8 = false;
    const LAS float* rsl; const float* shW;
    __device__ __forceinline__ void operator()(const f32x4 (&acc)[2][2][4][2], const pg8::Unit& u, int wr, int wc, int fr, int fq) const {
        bf16* base = (bf16*)u.o + (size_t)(wr * 64 + fr) * u.ldc + wc * 32 + 8 * fq;
        const float* sp = shW + (size_t)(u.row0 >> 12) * (2 * DFF) + u.col0 + wc * 32 + 8 * fq;
        float rs[2][4];
#pragma unroll
        for (int ai = 0; ai < 2; ++ai)
#pragma unroll
            for (int m = 0; m < 4; ++m) rs[ai][m] = rsl[u.aux * 256 + ai * pg8::HALF + wr * 64 + m * 16 + fr];
        f32x4 s1[2], s3[2];
#pragma unroll
        for (int n = 0; n < 2; ++n) { s1[n] = *(const f32x4*)(sp + 4 * n); s3[n] = *(const f32x4*)(sp + pg8::HALF + 4 * n); }
#pragma unroll
        for (int ai = 0; ai < 2; ++ai)
#pragma unroll
            for (int m = 0; m < 4; ++m) { bf16* rowp = base + (size_t)(ai * pg8::HALF + m * 16) * u.ldc;
                const float rstd = rs[ai][m];
                float r[8];
#pragma unroll
                for (int n = 0; n < 2; ++n)
#pragma unroll
                    for (int j = 0; j < 4; j += 2) {
                        const f32x2 A = (f32x2){acc[ai][0][m][n][j], acc[ai][0][m][n][j + 1]} * rstd + (f32x2){s1[n][j], s1[n][j + 1]}, B = (f32x2){acc[ai][1][m][n][j], acc[ai][1][m][n][j + 1]} * rstd + (f32x2){s3[n][j], s3[n][j + 1]};
                        const f32x2 t = A * (-1.4426950408889634f); f32x2 d; d.x = __builtin_amdgcn_exp2f(t.x); d.y = __builtin_amdgcn_exp2f(t.y); d = d + 1.0f;
                        f32x2 q; q.x = __builtin_amdgcn_rcpf(d.x); q.y = __builtin_amdgcn_rcpf(d.y);
                        const f32x2 o = (A * B) * q; r[n * 4 + j] = o.x; r[n * 4 + j + 1] = o.y; }
                u32x4 w; w.x = pk2(r[0], r[1]); w.y = pk2(r[2], r[3]); w.z = pk2(r[4], r[5]); w.w = pk2(r[6], r[7]);
                *(u32x4*)rowp = w; }
    }
};
struct EpiDftN {
    static constexpr bool PERM = true, FP8 = false;
    const LAS float* rsl; const float* dsh;
    __device__ __forceinline__ void operator()(const f32x4 (&acc)[2][2][4][2], const pg8::Unit& u, int wr, int wc, int fr, int fq) const {
        bf16* base = (bf16*)u.o + (size_t)(wr * 64 + fr) * u.ldc + wc * 32 + 8 * fq;
        f32x4 rs[2][2];
#pragma unroll
        for (int bj = 0; bj < 2; ++bj)
#pragma unroll
            for (int n = 0; n < 2; ++n) rs[bj][n] = *(const LAS f32x4*)(rsl + u.aux * 256 + bj * pg8::HALF + wc * 32 + 8 * fq + 4 * n);
#pragma unroll
        for (int ai = 0; ai < 2; ++ai)
#pragma unroll
            for (int m = 0; m < 4; ++m) { bf16* rowp = base + (size_t)(ai * pg8::HALF + m * 16) * u.ldc;
                const float sh = dsh[u.row0 * 256 + ai * pg8::HALF + wr * 64 + m * 16 + fr];
#pragma unroll
                for (int bj = 0; bj < 2; ++bj) *(u32x4*)(rowp + bj * pg8::HALF) = pk8(acc[ai][bj][m][0] * rs[bj][0] + sh, acc[ai][bj][m][1] * rs[bj][1] + sh); }
    }
};

constexpr int CV_NW = 64, CV_SCR = 128 * 33 * 4;
constexpr int I_IN = 16 * (NZ / CV_NW), I_SQ = 16 * (D / CV_NW), I_UP = 16 * (DFF / CV_NW), I_DN = (DFF / 64) * (D / CV_NW), CV_PLAIN = I_IN + 2 * I_SQ + 2 * I_UP + I_DN;
constexpr int I_MU = (D / 128) * (DFE / 32), I_MD = (DFE / 128) * (D / 32);
constexpr int MOE_ITEMS = NE * (2 * I_MU + I_MD), CV_ITEMS = CV_PLAIN + MOE_ITEMS;
constexpr int MOE_DEFER_P2 = 5000, MOE_DEFER_P6 = 3500;
struct CvJob { const float* src; bf16* dst; int N, ldt, f8; };
constexpr float W8_SCALE = 64.0f, H8_SCALE = 16.0f, A8_SCALE = 8.0f;
__device__ __forceinline__ void cv_plain(CvJob& j, const float* W, int K, int N, bf16* WT, int item) { const int nblk = N / CV_NW, kb = item / nblk, nb = item % nblk; j.src = W + (size_t)(64 * kb) * N + CV_NW * nb; j.dst = WT + (size_t)(CV_NW * nb) * K + 64 * kb; j.N = N; j.ldt = K; j.f8 = 0; }
__device__ __forceinline__ void cv_up(CvJob& j, const float* W, int K, int N, bf16* WT, int which, int item) { const int nblk = N / CV_NW, kb = item / nblk, nb = item % nblk, n0 = CV_NW * nb;
    j.src = W + (size_t)(64 * kb) * N + n0; j.dst = WT + (size_t)((n0 >> 7) * 256 + which * 128 + (n0 & 127)) * K + 64 * kb; j.N = N; j.ldt = K; j.f8 = 0; }
__device__ __forceinline__ void cv8_plain(CvJob& j, const float* W, int K, int N, unsigned char* WT, int item) { const int nblk = N / 32, kb = item / nblk, nb = item % nblk; j.src = W + (size_t)(128 * kb) * N + 32 * nb; j.dst = (bf16*)(WT + (size_t)(32 * nb) * K + 128 * kb); j.N = N; j.ldt = K; j.f8 = 1; }
__device__ __forceinline__ void cv8_up(CvJob& j, const float* W, int K, int N, unsigned char* WT, int which, int item) { const int nblk = N / 32, kb = item / nblk, nb = item % nblk, n0 = 32 * nb;
    j.src = W + (size_t)(128 * kb) * N + n0; j.dst = (bf16*)(WT + (size_t)((n0 >> 7) * 256 + which * 128 + (n0 & 127)) * K + 128 * kb); j.N = N; j.ldt = K; j.f8 = 1; }
__device__ __forceinline__ void cv_job(Frame& F, int it, CvJob& j) {
    int r = it;
    if (r < I_IN) { cv_plain(j, F.in[7], D, NZ, (bf16*)(F.ws + WS_WIN), r); return; } r -= I_IN;
    if (r < I_SQ) { cv_plain(j, F.in[18], D, D, (bf16*)(F.ws + WS_WMIX), r); return; } r -= I_SQ;
    if (r < I_SQ) { cv_plain(j, F.in[22], D, D, (bf16*)(F.ws + WS_WFOU), r); return; } r -= I_SQ;
    if (r < I_UP) { cv_up(j, F.in[19], D, DFF, (bf16*)(F.ws + WS_WUP), 0, r); return; } r -= I_UP;
    if (r < I_UP) { cv_up(j, F.in[20], D, DFF, (bf16*)(F.ws + WS_WUP), 1, r); return; } r -= I_UP;
    if (r < I_DN) { cv_plain(j, F.in[21], DFF, D, (bf16*)(F.ws + WS_WDN), r); return; } r -= I_DN;
    if (r < NE * I_MU) { const int e = r / I_MU; cv8_up(j, F.in[25] + (size_t)e * D * DFE, D, DFE, F.ws + WS_MOEUP + (size_t)e * 2 * DFE * D, 0, r % I_MU); return; } r -= NE * I_MU;
    if (r < NE * I_MU) { const int e = r / I_MU; cv8_up(j, F.in[26] + (size_t)e * D * DFE, D, DFE, F.ws + WS_MOEUP + (size_t)e * 2 * DFE * D, 1, r % I_MU); return; } r -= NE * I_MU;
    { const int e = r / I_MD; cv8_plain(j, F.in[27] + (size_t)e * DFE * D, DFE, D, F.ws + WS_MOEDN + (size_t)e * D * DFE, r % I_MD); }
}
__device__ __forceinline__ void cv_load(const CvJob& j, int lane, f32x4 (&v)[16]) {
    const int rs = j.f8 ? 8 : 4, lr = j.f8 ? (lane >> 3) : (lane >> 4), lc = j.f8 ? 4 * (lane & 7) : 4 * (lane & 15);
    const float* src = j.src + (size_t)lr * j.N + lc;
#pragma unroll
    for (int i = 0; i < 16; ++i) v[i] = __builtin_nontemporal_load((const f32x4*)(src + (size_t)(rs * i) * j.N));
}
__device__ __forceinline__ void cv_store(const CvJob& j, int lane, const f32x4 (&v)[16], LAS float* scr) {
    if (j.f8) {
        const int lr = lane >> 3, lc = 4 * (lane & 7);
#pragma unroll
        for (int i = 0; i < 16; ++i) { LAS float* d = scr + (8 * i + lr) * 33 + lc; d[0] = v[i].x; d[1] = v[i].y; d[2] = v[i].z; d[3] = v[i].w; }
        LDS_WAIT(); asm volatile("" ::: "memory");
        const int c = lane & 7;
#pragma unroll
        for (int q = 0; q < 4; ++q) { const int n = (lane >> 3) + 8 * q; const LAS float* s = scr + (16 * c) * 33 + n;
            u32x4 o;
            o.x = pg8::pk4_fp8(s[0 * 33] * W8_SCALE, s[1 * 33] * W8_SCALE, s[2 * 33] * W8_SCALE, s[3 * 33] * W8_SCALE); o.y = pg8::pk4_fp8(s[4 * 33] * W8_SCALE, s[5 * 33] * W8_SCALE, s[6 * 33] * W8_SCALE, s[7 * 33] * W8_SCALE);
            o.z = pg8::pk4_fp8(s[8 * 33] * W8_SCALE, s[9 * 33] * W8_SCALE, s[10 * 33] * W8_SCALE, s[11 * 33] * W8_SCALE); o.w = pg8::pk4_fp8(s[12 * 33] * W8_SCALE, s[13 * 33] * W8_SCALE, s[14 * 33] * W8_SCALE, s[15 * 33] * W8_SCALE);
            *(u32x4*)((unsigned char*)j.dst + (size_t)n * j.ldt + 16 * c) = o; }
    } else {
        const int lr = lane >> 4, lc = 4 * (lane & 15);
#pragma unroll
        for (int i = 0; i < 16; ++i) { LAS float* d = scr + (4 * i + lr) * 65 + lc; d[0] = v[i].x; d[1] = v[i].y; d[2] = v[i].z; d[3] = v[i].w; }
        LDS_WAIT(); asm volatile("" ::: "memory");
        const int c = lane & 7;
#pragma unroll
        for (int q = 0; q < 8; ++q) { const int n = (lane >> 3) + 8 * q; const LAS float* s = scr + (8 * c) * 65 + n;
            u32x4 o; o.x = pk2(s[0 * 65], s[1 * 65]); o.y = pk2(s[2 * 65], s[3 * 65]); o.z = pk2(s[4 * 65], s[5 * 65]); o.w = pk2(s[6 * 65], s[7 * 65]);
            *(u32x4*)(j.dst + (size_t)n * j.ldt + 8 * c) = o; }
    }
    LDS_WAIT(); asm volatile("" ::: "memory");
}
__device__ __forceinline__ void convert_items(Frame& F, int lo, int hi, int w, int nw, LAS float* scr) {
    int it = lo + w; if (it >= hi) return;
    CvJob ja, jb; f32x4 va[16], vb[16];
    cv_job(F, it, ja); cv_load(ja, F.lane, va);
    for (;;) {
        const int itb = it + nw; const bool hb = itb < hi;
        if (hb) { cv_job(F, itb, jb); cv_load(jb, F.lane, vb); }
        cv_store(ja, F.lane, va, scr);
        if (!hb) break;
        const int ita = itb + nw; const bool ha = ita < hi;
        if (ha) { cv_job(F, ita, ja); cv_load(ja, F.lane, va); }
        cv_store(jb, F.lane, vb, scr);
        if (!ha) break;
        it = ita;
    }
}
__device__ __forceinline__ void moe_tail_convert(Frame& F, int nunits, int lo, int hi) {
    const int rem = nunits % F.G;
    if (rem == 0 || F.bid < rem) return;
    convert_items(F, lo, hi, (F.bid - rem) * NWAVES + F.wave, (F.G - rem) * NWAVES, (LAS float*)(F.lds + F.wave * CV_SCR));
}

__device__ __forceinline__ void p0_prologue(Frame& F) {
    const int tid = F.tid;
    LAS float* sil = (LAS float*)(F.lds);
    LAS float* red = (LAS float*)(F.lds + 20480);
    LAS float* feats = (LAS float*)(F.lds + 61440);
    LAS float* hid1 = (LAS float*)(F.lds + 65536);
    LAS float* hid2 = (LAS float*)(F.lds + 69632);
    const float* cvec = F.in[1]; const float* cctx = F.in[3];
    for (int i = tid; i < 5 * 1024; i += NTHR) { const float v = i < 4096 ? cvec[i] : cctx[i - 4096]; sil[i] = v / (1.0f + __expf(-v)); }
    __syncthreads();
    float* MOD = (float*)(F.ws + WS_MOD);
    float* KT = (float*)(F.ws + WS_KT);
    for (int it = F.bid; it < 192 + 256; it += F.G) {
        if (it < 192) {
            const int l = it / 96, s = it % 96, cq = tid & 15, kg = tid >> 4;
            const float* W = F.in[4] + (size_t)l * D * NMOD + 64 * s + 4 * cq;
            f32x4 a[5];
#pragma unroll
            for (int r = 0; r < 5; ++r) a[r] = (f32x4){0.f, 0.f, 0.f, 0.f};
#pragma unroll 16
            for (int k = kg * 32; k < kg * 32 + 32; ++k) { const f32x4 w = *(const f32x4*)(W + (size_t)k * NMOD);
#pragma unroll
                for (int r = 0; r < 5; ++r) a[r] += sil[r * 1024 + k] * w; }
#pragma unroll
            for (int r = 0; r < 5; ++r) *(LAS f32x4*)(red + (kg * 5 + r) * 64 + 4 * cq) = a[r];
            __syncthreads();
            if (tid < 320) { const int r = tid >> 6, cc = tid & 63; float sum = F.in[5][l * NMOD + 64 * s + cc];
#pragma unroll 8
                for (int q = 0; q < 32; ++q) sum += red[(q * 5 + r) * 64 + cc];
                MOD[(size_t)(l * 5 + r) * NMOD + 64 * s + cc] = sum; }
            __syncthreads();
        } else {
            const int fi = it - 192, t0 = 16 * ((fi & ~9) | ((fi & 1) << 3) | ((fi >> 3) & 1));
            for (int idx = tid; idx < 16 * 33; idx += NTHR) { const int r = idx / 33, f = idx % 33; const float n = (float)(t0 + r); float v;
                if (f == 0) v = n * (1.0f / 4095.0f);
                else { const int j = (f - 1) & 15; const float band = 1e-4f + (float)j * ((15.0f - 1e-4f) / 15.0f); const float ang = (6.283185307179586f / 4096.0f) * n * band; v = (f <= 16) ? cosf(ang) : -sinf(ang); }
                feats[idx] = v; }
            __syncthreads();
            for (int idx = tid; idx < 1024; idx += NTHR) { const int r = idx >> 6, j = idx & 63; float s = F.in[11][j];
                for (int f = 0; f < 33; ++f) s += feats[r * 33 + f] * F.in[10][f * 64 + j];
                hid1[idx] = sinf(F.in[15][j] * s); }
            __syncthreads();
            for (int idx = tid; idx < 1024; idx += NTHR) { const int r = idx >> 6, j = idx & 63; float s = F.in[13][j];
                for (int i = 0; i < 64; ++i) s += hid1[r * 64 + i] * F.in[12][i * 64 + j];
                hid2[idx] = sinf(F.in[15][64 + j] * s); }
            __syncthreads();
            { const int col4 = tid * 4; f32x4 acc[16];
#pragma unroll
              for (int r = 0; r < 16; ++r) acc[r] = (f32x4){0.f, 0.f, 0.f, 0.f};
              for (int j = 0; j < 64; ++j) { const f32x4 w = *(const f32x4*)(F.in[14] + j * 2048 + col4);
#pragma unroll
                  for (int r = 0; r < 16; ++r) acc[r] += hid2[r * 64 + j] * w; }
#pragma unroll
              for (int e = 0; e < 4; ++e) { const int col = col4 + e, c = col & 511, od = col >> 9;
                  const float delta = 3.0701134573253944f + (float)c * ((15.350567286626972f - 3.0701134573253944f) / 511.0f);
                  float* dst = KT + ((size_t)od * 512 + c) * 4096 + t0;
#pragma unroll
                  for (int r4 = 0; r4 < 4; ++r4) { f32x4 o;
#pragma unroll
                      for (int q = 0; q < 4; ++q) { const int r = r4 * 4 + q; const float t = (float)(t0 + r) * (1.0f / 4095.0f); o[q] = acc[r][e] * __expf(-t * delta); }
                      *(f32x4*)(dst + r4 * 4) = o; } } }
            __syncthreads();
        }
    }
    __syncthreads();
    convert_items(F, 0, CV_ITEMS - MOE_DEFER_P2 - MOE_DEFER_P6, F.bid * NWAVES + F.wave, F.G * NWAVES, (LAS float*)(F.lds + F.wave * CV_SCR));
    bf16* DC = (bf16*)(F.ws + WS_DFTCH);
    for (int idx = F.bid * NTHR + tid; idx < 256 * 256; idx += F.G * NTHR) { const int row = idx >> 8, j = idx & 255, cs = row >= 129, k = cs ? row - 128 : row, m = (j * k) & 255;
        const float ang = (float)m * (6.283185307179586f / 256.0f); const float v = (cs ? sinf(ang) : cosf(ang)) * (1.0f / 16.0f);
        DC[idx] = (bf16)(pk2(v, 0.f) & 0xffffu); }
}

__device__ __forceinline__ void norm_phase(Frame& F, const float* src_main, int n_main, bf16* dst_main, const float* src_ctx, int n_ctx, bf16* dst_ctx, const float* g, const float* mod, int ish, int isc) {
    LAS float* gs = (LAS float*)(F.lds);
    LAS float* sv = (LAS float*)(F.lds + 20480);
    for (int i = F.tid; i < 5 * 1024; i += NTHR) { const int b = i >> 10, k = i & 1023; gs[i] = g[k] * (1.0f + mod[(size_t)b * NMOD + isc * D + k]); sv[i] = mod[(size_t)b * NMOD + ish * D + k]; }
    __syncthreads();
    const int gw = F.bid * NWAVES + F.wave, NGW = F.G * NWAVES;
    for (int row = gw; row < n_main + n_ctx; row += NGW) {
        const bool isctx = row >= n_main; const int b = isctx ? 4 : (row >> 12);
        const float* xr = isctx ? src_ctx + (size_t)(row - n_main) * D : src_main + (size_t)row * D;
        bf16* orow = isctx ? dst_ctx + (size_t)(row - n_main) * D : dst_main + (size_t)row * D;
        f32x4 v[4]; float s = 0.f;
#pragma unroll
        for (int j = 0; j < 4; ++j) { v[j] = *((const f32x4*)xr + F.lane + 64 * j); s += (v[j].x * v[j].x + v[j].y * v[j].y) + (v[j].z * v[j].z + v[j].w * v[j].w); }
        const float rstd = 1.0f / sqrtf(wave_sum(s) * (1.0f / D) + EPS);
#pragma unroll
        for (int j = 0; j < 4; ++j) { const int k = 4 * F.lane + 256 * j; const f32x4 a = *(const LAS f32x4*)(gs + b * 1024 + k), c = *(const LAS f32x4*)(sv + b * 1024 + k);
            const f32x4 o = v[j] * rstd * a + c;
            u32x2 w; w.x = pk2(o.x, o.y); w.y = pk2(o.z, o.w); *((u32x2*)orow + F.lane + 64 * j) = w; }
    }
    __syncthreads();
}

__device__ __forceinline__ void shift_gemvs(Frame& F, const float* mod0, const float* mod1) {
    const bf16* WUP = (const bf16*)(F.ws + WS_WUP); const bf16* DC = (const bf16*)(F.ws + WS_DFTCH);
    float* SHW = (float*)(F.ws + WS_SHW); float* DSH = (float*)(F.ws + WS_DSH);
    const int gw = F.bid * NWAVES + F.wave, NGW = F.G * NWAVES, lane = F.lane;
    for (int it = gw; it < 2 * DFF + 16 * 256; it += NGW) {
        if (it < 2 * DFF) {
            const u32x4 w0 = *(const u32x4*)(WUP + (size_t)it * D + 8 * lane), w1 = *(const u32x4*)(WUP + (size_t)it * D + 512 + 8 * lane);
            float wf[16];
            wf[0] = __uint_as_float(w0.x << 16); wf[1] = __uint_as_float(w0.x & 0xffff0000u); wf[2] = __uint_as_float(w0.y << 16); wf[3] = __uint_as_float(w0.y & 0xffff0000u);
            wf[4] = __uint_as_float(w0.z << 16); wf[5] = __uint_as_float(w0.z & 0xffff0000u); wf[6] = __uint_as_float(w0.w << 16); wf[7] = __uint_as_float(w0.w & 0xffff0000u);
            wf[8] = __uint_as_float(w1.x << 16); wf[9] = __uint_as_float(w1.x & 0xffff0000u); wf[10] = __uint_as_float(w1.y << 16); wf[11] = __uint_as_float(w1.y & 0xffff0000u);
            wf[12] = __uint_as_float(w1.z << 16); wf[13] = __uint_as_float(w1.z & 0xffff0000u); wf[14] = __uint_as_float(w1.w << 16); wf[15] = __uint_as_float(w1.w & 0xffff0000u);
            float a[4];
#pragma unroll
            for (int b = 0; b < 4; ++b) { const float* sh = mod0 + (size_t)b * NMOD + 3 * D; float t = 0.f;
#pragma unroll
                for (int h = 0; h < 2; ++h) { const f32x4 s0 = *(const f32x4*)(sh + 512 * h + 8 * lane), s1 = *(const f32x4*)(sh + 512 * h + 8 * lane + 4);
                    t += wf[8 * h] * s0.x + wf[8 * h + 1] * s0.y + wf[8 * h + 2] * s0.z + wf[8 * h + 3] * s0.w + wf[8 * h + 4] * s1.x + wf[8 * h + 5] * s1.y + wf[8 * h + 6] * s1.z + wf[8 * h + 7] * s1.w; }
                a[b] = wave_sum(t); }
            if (lane < 4) SHW[(size_t)lane * (2 * DFF) + it] = lane == 0 ? a[0] : lane == 1 ? a[1] : lane == 2 ? a[2] : a[3];
        } else {
            const int o = it - 2 * DFF, bg = o >> 8, r = o & 255, b = bg >> 2, g = bg & 3;
            const u32x2 w = *(const u32x2*)(DC + (size_t)r * 256 + 4 * lane); const f32x4 sv = *(const f32x4*)(mod1 + (size_t)b * NMOD + 0 * D + g * 256 + 4 * lane);
            const float t = wave_sum(__uint_as_float(w.x << 16) * sv.x + __uint_as_float(w.x & 0xffff0000u) * sv.y + __uint_as_float(w.y << 16) * sv.z + __uint_as_float(w.y & 0xffff0000u) * sv.w);
            if (lane == 0) DSH[o] = t;
        }
    }
}

struct SchedIn {
    int G, c; unsigned char* ws;
    __device__ __forceinline__ bool next(int i, pg8::Unit& u) const {
        int L = i * G + c; if (L >= 784) return false;
        const char* H = (const char*)(ws + WS_H); const char* HC = (const char*)(ws + WS_HC); const char* W = (const char*)(ws + WS_WIN);
        int pm, pn; u.row0 = 0; u.col0 = 0;
        if (L < 384) { pg8::grid_unit(L, 6, 64, pm, pn);
            u.a = W + (size_t)pm * 256 * 2048; u.b = H + (size_t)pn * 256 * 2048; u.o = (char*)(ws + WS_HYT) + ((size_t)pm * 256 * NT + pn * 256) * 2; u.ldc = NT; return true; } L -= 384;
        if (L < 256) { pg8::grid_unit(L, 64, 4, pm, pn);
            u.a = H + (size_t)pm * 256 * 2048; u.b = W + (size_t)(1536 + pn * 256) * 2048; u.o = (char*)(ws + WS_QK) + ((size_t)pm * 256 * 1024 + pn * 256) * 2; u.ldc = 1024; return true; } L -= 256;
        if (L < 128) { pg8::grid_unit(L, 2, 64, pm, pn);
            u.a = W + (size_t)(2560 + pm * 256) * 2048; u.b = H + (size_t)pn * 256 * 2048; u.o = (char*)(ws + WS_VT) + ((size_t)pm * 256 * NT + pn * 256) * 2; u.ldc = NT; return true; } L -= 128;
        if (L < 8) { pm = L >> 1; pn = L & 1;
            u.a = HC + (size_t)pm * 256 * 2048; u.b = W + (size_t)(2048 + pn * 256) * 2048; u.o = (char*)(ws + WS_KC) + ((size_t)pm * 256 * 512 + pn * 256) * 2; u.ldc = 512; return true; } L -= 8;
        { pm = L >> 2; pn = L & 3;
            u.a = W + (size_t)(2560 + pm * 256) * 2048; u.b = HC + (size_t)pn * 256 * 2048; u.o = (char*)(ws + WS_VCT) + ((size_t)pm * 256 * NCTX + pn * 256) * 2; u.ldc = NCTX; return true; }
    }
};
struct SchedPlain {
    int G, c, nM, nN; const char* A; const char* B; char* O; int lda, ldb, ldc, ocol, osz;
    __device__ __forceinline__ bool next(int i, pg8::Unit& u) const {
        const int L = i * G + c; if (L >= nM * nN) return false;
        int pm, pn; pg8::grid_unit(L, nM, nN, pm, pn);
        u.a = A + (size_t)pm * 256 * lda * 2; u.b = B + (size_t)pn * 256 * ldb * 2; u.o = O + ((size_t)pm * 256 * ldc + (size_t)pn * ocol) * osz; u.ldc = ldc; u.row0 = pm * 256; u.col0 = pn * 256; u.aux = i; return true;
    }
};
struct SchedChDft {
    int G, c; unsigned char* ws;
    __device__ __forceinline__ bool next(int i, pg8::Unit& u) const {
        const int L = i * G + c; if (L >= 256) return false;
        const int g = L & 3, pn = L >> 2;
        const int b = pn >> 4, t0 = (pn & 15) * 256;
        u.a = (const char*)(ws + WS_DFTCH); u.b = (const char*)(ws + WS_H) + ((size_t)pn * 256 * 1024 + g * 256) * 2;
        u.o = (char*)(ws + WS_PQT) + ((size_t)((b * 4 + g) * 256) * 4096 + t0) * 2; u.ldc = 4096; u.row0 = b * 4 + g; u.col0 = pn * 256; u.aux = i; return true;
    }
};
struct SchedMoe {
    int G, c, nN; int tb[9]; const char* A; const char* B; char* O; int lda, ldb, ldc, ocol; size_t bstride;
    int sparseA;
    __device__ __forceinline__ bool next(int i, pg8::Unit& u) const {
        const int L = i * G + c; const int T = tb[8]; if (L >= T * nN) return false;
        int pm, pn; pg8::grid_unit(L, T, nN, pm, pn);
        int e = 0;
#pragma unroll
        for (int q = 1; q < 8; ++q) e += (pm >= tb[q]) ? 1 : 0;
        int tbe = 0;
#pragma unroll
        for (int q = 0; q < 8; ++q) tbe = (q == e) ? tb[q] : tbe;
        u.a = A + (sparseA ? ((size_t)e * NT + (size_t)(pm - tbe) * 256) : (size_t)pm * 256) * lda * 2; u.b = B + (size_t)e * bstride + (size_t)pn * 256 * ldb * 2; u.o = O + ((size_t)pm * 256 * ldc + (size_t)pn * ocol) * 2; u.ldc = ldc; u.row0 = pm * 256; u.col0 = pn * 256; return true;
    }
};

__device__ __forceinline__ f32x4 mfma16(bf16x8 a, bf16x8 b, f32x4 c) { return __builtin_amdgcn_mfma_f32_16x16x32_bf16(a, b, c, 0, 0, 0); }

constexpr int NA_KS = 0, NA_VS = 45056, NA_KCS = 95744, NA_VCS = 112128, NA_RP = 129024, NA_MAXROWS = 11;
template <bool LOCAL> __device__ __forceinline__ void na_half(Frame& F, int lane_, bf16x8 qf, int r, int r0, int krel0, int qcol, int cstart, int bstart, float& mx_out, float& l_out, f32x4& o0, f32x4& o1) {
    const LAS float* rp = (const LAS float*)(F.lds + NA_RP);
    asm volatile("" : "+v"(lane_));
    const int i = lane_ & 15, g = lane_ >> 4;
    const f32x4 zero4 = (f32x4){0.f, 0.f, 0.f, 0.f};
    f32x4 sc[16];
#pragma unroll
    for (int t0 = 0; t0 < 16; t0 += 4) {
        bf16x8 kf[4];
#pragma unroll
        for (int t = 0; t < 4; ++t) { const int tt = t0 + t;
            const int key = LOCAL ? (bstart + 16 * (tt & 1) + i) : (16 * tt + i);
            const int off = (LOCAL ? (NA_KS + (krel0 + (tt >> 1)) * 4096) : NA_KCS) + key * 64 + ((g ^ ((key >> 2) & 3)) << 4);
            kf[t] = *(const LAS bf16x8*)(F.lds + off); }
#pragma unroll
        for (int t = 0; t < 4; ++t) sc[t0 + t] = mfma16(kf[t], qf, zero4);
        __builtin_amdgcn_sched_barrier(0);
    }
    float mx = -1e30f, l = 0.f;
    if (LOCAL) {
        const int w0 = cstart - bstart;
#pragma unroll
        for (int rr = 0; rr < 8; ++rr)
#pragma unroll
            for (int jj = 0; jj < 4; ++jj) { const int pos = 4 * g + jj; const bool lo = pos >= w0;
                const float m = lo ? sc[2 * rr][jj] : sc[2 * rr + 1][jj];
                const float v = m + rp[(r0 + rr - r + 7) * 31 + bstart + pos + (lo ? 0 : 16) - qcol + 15];
                sc[2 * rr][jj] = v; mx = fmaxf(mx, v); }
        mx = fmaxf(mx, __shfl_xor(mx, 16)); mx = fmaxf(mx, __shfl_xor(mx, 32));
#pragma unroll
        for (int rr = 0; rr < 8; ++rr)
#pragma unroll
            for (int jj = 0; jj < 4; ++jj) { const int pos = 4 * g + jj; const bool lo = pos >= w0;
                const float p = __builtin_amdgcn_exp2f(sc[2 * rr][jj] - mx); l += p;
                sc[2 * rr][jj] = lo ? p : 0.f; sc[2 * rr + 1][jj] = lo ? 0.f : p; }
    } else {
#pragma unroll
        for (int tt = 0; tt < 16; ++tt)
#pragma unroll
            for (int jj = 0; jj < 4; ++jj) mx = fmaxf(mx, sc[tt][jj]);
        mx = fmaxf(mx, __shfl_xor(mx, 16)); mx = fmaxf(mx, __shfl_xor(mx, 32));
#pragma unroll
        for (int tt = 0; tt < 16; ++tt)
#pragma unroll
            for (int jj = 0; jj < 4; ++jj) { const float p = __builtin_amdgcn_exp2f(sc[tt][jj] - mx); sc[tt][jj] = p; l += p; }
    }
    l += __shfl_xor(l, 16); l += __shfl_xor(l, 32);
    o0 = zero4; o1 = zero4;
#pragma unroll
    for (int ks = 0; ks < 8; ++ks) {
        union { u32x4 u; bf16x8 v; } pf, v0, v1;
        pf.u.x = pk2(sc[2 * ks][0], sc[2 * ks][1]); pf.u.y = pk2(sc[2 * ks][2], sc[2 * ks][3]); pf.u.z = pk2(sc[2 * ks + 1][0], sc[2 * ks + 1][1]); pf.u.w = pk2(sc[2 * ks + 1][2], sc[2 * ks + 1][3]);
        const int vb = LOCAL ? (NA_VS + ((krel0 + ks) * 32 + i) * 144 + (bstart + 4 * g) * 2) : (NA_VCS + i * 528 + (32 * ks + 4 * g) * 2);
        const int dstep = LOCAL ? 16 * 144 : 16 * 528;
        const u32x2 a = *(const LAS u32x2*)(F.lds + vb), bq = *(const LAS u32x2*)(F.lds + vb + 32), c2 = *(const LAS u32x2*)(F.lds + vb + dstep), d2 = *(const LAS u32x2*)(F.lds + vb + dstep + 32);
        v0.u.x = a.x; v0.u.y = a.y; v0.u.z = bq.x; v0.u.w = bq.y; v1.u.x = c2.x; v1.u.y = c2.y; v1.u.z = d2.x; v1.u.w = d2.y;
        o0 = mfma16(v0.v, pf.v, o0); o1 = mfma16(v1.v, pf.v, o1);
        if ((ks & 1) == 1) __builtin_amdgcn_sched_barrier(0);
    }
    mx_out = mx; l_out = l;
}
__device__ __forceinline__ void na_unit(Frame& F, int b, int h, int r, int j, int krow_lo) {
    const bf16* QK = (const bf16*)(F.ws + WS_QK); bf16* YC = (bf16*)(F.ws + WS_YCAT);
    int lane_ = F.lane; asm volatile("" : "+v"(lane_));
    const int i = lane_ & 15, g = lane_ >> 4;
    const int qcol = 16 * j + i;
    const int cstart = min(max(qcol - 8, 0), 48), bstart = min(max(16 * j - 8, 0), 32), r0 = min(max(r - 4, 0), 56);
    const size_t tokq = (size_t)b * SEQ + r * 64 + qcol;
    bf16x8 qf;
    { const u32x4 qr = *(const u32x4*)(QK + tokq * 1024 + h * 32 + 8 * g); const float qs = 0.17677669529663687f * 1.4426950408889634f;
      union { u32x4 u; bf16x8 v; } qq;
      qq.u.x = pk2(__uint_as_float(qr.x << 16) * qs, __uint_as_float(qr.x & 0xffff0000u) * qs); qq.u.y = pk2(__uint_as_float(qr.y << 16) * qs, __uint_as_float(qr.y & 0xffff0000u) * qs);
      qq.u.z = pk2(__uint_as_float(qr.z << 16) * qs, __uint_as_float(qr.z & 0xffff0000u) * qs); qq.u.w = pk2(__uint_as_float(qr.w << 16) * qs, __uint_as_float(qr.w & 0xffff0000u) * qs);
      qf = qq.v; }
    float mA, lA, mB, lB; f32x4 a0, a1, b0, b1;
    na_half<true>(F, lane_, qf, r, r0, r0 - krow_lo, qcol, cstart, bstart, mA, lA, a0, a1);
    na_half<false>(F, lane_, qf, r, r0, r0 - krow_lo, qcol, cstart, bstart, mB, lB, b0, b1);
    const float m = fmaxf(mA, mB), fA = __builtin_amdgcn_exp2f(mA - m), fB = __builtin_amdgcn_exp2f(mB - m);
    const float inv = 1.0f / (lA * fA + lB * fB), ca = fA * inv, cb = fB * inv;
    const f32x4 o0 = a0 * ca + b0 * cb, o1 = a1 * ca + b1 * cb;
    bf16* yo = YC + tokq * 1024 + 512 + h * 32 + 4 * g;
    u32x2 w0, w1; w0.x = pk2(o0[0], o0[1]); w0.y = pk2(o0[2], o0[3]); w1.x = pk2(o1[0], o1[1]); w1.y = pk2(o1[2], o1[3]);
    *(u32x2*)yo = w0; *(u32x2*)(yo + 16) = w1;
}
__device__ __forceinline__ void na_task(Frame& F, int task) {
    const int b = task >> 6, h = ((task >> 4) & 3) * 4 + ((task >> 2) & 1) * 2 + ((task >> 3) & 1), quarter = task & 3, tid = F.tid;
    const bf16* QK = (const bf16*)(F.ws + WS_QK); const bf16* VT = (const bf16*)(F.ws + WS_VT);
    const bf16* KC = (const bf16*)(F.ws + WS_KC); const bf16* VCT = (const bf16*)(F.ws + WS_VCT);
    __syncthreads();
    LAS float* rp = (LAS float*)(F.lds + NA_RP);
    for (int i = tid; i < 465; i += NTHR) rp[i] = F.in[17][h * 465 + i] * 1.4426950408889634f;
    for (int ch = tid; ch < 1024; ch += NTHR) { const int key = ch >> 2, gq = ch & 3;
        *(LAS u32x4*)(F.lds + NA_KCS + key * 64 + ((gq ^ ((key >> 2) & 3)) << 4)) = *(const u32x4*)(KC + (size_t)(b * CTX + key) * 512 + h * 32 + gq * 8); }
    for (int ch = tid; ch < 1024; ch += NTHR) { const int d = ch >> 5, c = ch & 31;
        *(LAS u32x4*)(F.lds + NA_VCS + d * 528 + c * 16) = *(const u32x4*)(VCT + (size_t)(h * 32 + d) * NCTX + b * CTX + 8 * c); }
#pragma unroll 1
    for (int ti = 0; ti < 4; ++ti) {
        const int rq = 16 * quarter + 4 * ti;
        const int krow_lo = min(max(rq - 4, 0), 56), krow_hi = min(max(rq + 3 - 4, 0), 56) + 7, nrows = krow_hi - krow_lo + 1;
        __syncthreads();
        for (int ch = tid; ch < nrows * 256; ch += NTHR) { const int kr = ch >> 8, key = (ch >> 2) & 63, gq = ch & 3;
            *(LAS u32x4*)(F.lds + NA_KS + kr * 4096 + key * 64 + ((gq ^ ((key >> 2) & 3)) << 4)) = *(const u32x4*)(QK + ((size_t)b * SEQ + (krow_lo + kr) * 64 + key) * 1024 + 512 + h * 32 + gq * 8); }
        for (int ch = tid; ch < nrows * 256; ch += NTHR) { const int kr = ch >> 8, d = (ch >> 3) & 31, c = ch & 7;
            *(LAS u32x4*)(F.lds + NA_VS + (kr * 32 + d) * 144 + c * 16) = *(const u32x4*)(VT + (size_t)(h * 32 + d) * NT + (size_t)b * SEQ + (krow_lo + kr) * 64 + 8 * c); }
        __syncthreads();
        const int r = rq + (F.wave >> 1);
#pragma unroll 1
        for (int jj = 0; jj < 2; ++jj) na_unit(F, b, h, r, 2 * (F.wave & 1) + jj, krow_lo);
    }
    __syncthreads();
}

__device__ __forceinline__ f32x2 cmul(f32x2 a, f32x2 b) {
    f32x2 t, r;
    asm("v_pk_mul_f32 %0, %1, %2 op_sel_hi:[0,1]" : "=v"(t) : "v"(a), "v"(b));
    asm("v_pk_fma_f32 %0, %1, %2, %3 op_sel:[1,1,0] op_sel_hi:[1,0,1] neg_lo:[0,1,0]" : "=v"(r) : "v"(a), "v"(b), "v"(t));
    return r;
}
__device__ __forceinline__ f32x2 cmulc(f32x2 a, f32x2 b) {
    f32x2 t, r;
    asm("v_pk_mul_f32 %0, %1, %2 op_sel_hi:[0,1] neg_hi:[0,1]" : "=v"(t) : "v"(a), "v"(b));
    asm("v_pk_fma_f32 %0, %1, %2, %3 op_sel:[1,1,0] op_sel_hi:[1,0,1]" : "=v"(r) : "v"(a), "v"(b), "v"(t));
    return r;
}
__device__ __forceinline__ f32x2 add_mi(f32x2 a, f32x2 b) { f32x2 r; asm("v_pk_add_f32 %0, %1, %2 op_sel:[0,1] op_sel_hi:[1,0] neg_hi:[0,1]" : "=v"(r) : "v"(a), "v"(b)); return r; }
__device__ __forceinline__ f32x2 add_pi(f32x2 a, f32x2 b) { f32x2 r; asm("v_pk_add_f32 %0, %1, %2 op_sel:[0,1] op_sel_hi:[1,0] neg_lo:[0,1]" : "=v"(r) : "v"(a), "v"(b)); return r; }
template <bool INV> __device__ __forceinline__ void dft4(f32x2& a, f32x2& b, f32x2& c, f32x2& d) {
    const f32x2 t0 = a + c, t1 = a - c, t2 = b + d, t3 = b - d;
    a = t0 + t2; c = t0 - t2;
    b = INV ? add_pi(t1, t3) : add_mi(t1, t3); d = INV ? add_mi(t1, t3) : add_pi(t1, t3);
}
template <bool INV> __device__ __forceinline__ f32x2 tw16(f32x2 v, int e) {
    constexpr float C1 = 0.9238795325112867f, S1 = 0.3826834323650898f, R = 0.7071067811865476f;
    float c, s;
    switch (e) { case 0: return v; case 1: c = C1; s = S1; break; case 2: c = R; s = R; break; case 3: c = S1; s = C1; break;
                 case 4: { const f32x2 z = (f32x2){0.f, 0.f}; return INV ? add_pi(z, v) : add_mi(z, v); }
                 case 6: c = -R; s = R; break; default: c = -C1; s = -S1; break;   }
    const f32x2 w = (f32x2){c, INV ? s : -s};
    return cmul(v, w);
}
template <bool INV> __device__ __forceinline__ void dft16(f32x2 (&x)[16]) {
#pragma unroll
    for (int b = 0; b < 4; ++b) dft4<INV>(x[b], x[4 + b], x[8 + b], x[12 + b]);
#pragma unroll
    for (int b = 1; b < 4; ++b)
#pragma unroll
        for (int c = 1; c < 4; ++c) x[4 * c + b] = tw16<INV>(x[4 * c + b], b * c);
    f32x2 y[16];
#pragma unroll
    for (int c = 0; c < 4; ++c) { f32x2 p0 = x[4 * c + 0], p1 = x[4 * c + 1], p2 = x[4 * c + 2], p3 = x[4 * c + 3]; dft4<INV>(p0, p1, p2, p3); y[c] = p0; y[c + 4] = p1; y[c + 8] = p2; y[c + 12] = p3; }
#pragma unroll
    for (int k = 0; k < 16; ++k) x[k] = y[k];
}
struct HyTw { f32x2 w1, w2, w3, w4, w8; };
#ifndef HY_HALF_BARRIER
#define HY_HALF_BARRIER 0
#endif
struct HBar { LAS unsigned* cnt; unsigned target; };
__device__ __forceinline__ void hbar(HBar& hb, int lane) {
#if HY_HALF_BARRIER
    asm volatile("s_waitcnt lgkmcnt(0)" ::: "memory");
    hb.target += 4u;
    if (lane == 0) (void)__hip_atomic_fetch_add(hb.cnt, 1u, __ATOMIC_RELAXED, __HIP_MEMORY_SCOPE_WORKGROUP);
    while (__hip_atomic_load(hb.cnt, __ATOMIC_RELAXED, __HIP_MEMORY_SCOPE_WORKGROUP) < hb.target) __builtin_amdgcn_s_sleep(1);
    asm volatile("" ::: "memory");
#else
    (void)hb; (void)lane;
    asm volatile("s_waitcnt lgkmcnt(0)" ::: "memory"); __builtin_amdgcn_s_barrier(); asm volatile("" ::: "memory");
#endif
}
__device__ __forceinline__ f32x2 opq(f32x2 v) { float a = v.x, b = v.y; asm volatile("" : "+v"(a), "+v"(b)); return (f32x2){a, b}; }
__device__ __forceinline__ void hy_fwd(f32x2 (&x)[16], LAS f32x2* buf, int p, const HyTw& T, HBar& hb, int lane) {
    hbar(hb, lane);
    dft16<false>(x);
    { const f32x2 w0 = opq(T.w1); f32x2 w = w0;
#pragma unroll
      for (int k = 1; k < 16; ++k) { x[k] = cmul(x[k], w); w = cmul(w, w0); } }
    const int a1 = p + (p >> 4);
#pragma unroll
    for (int k = 0; k < 16; ++k) buf[272 * k + a1] = x[k];
    hbar(hb, lane);
    const int a2 = 272 * (p >> 4) + (p & 15);
#pragma unroll
    for (int k = 0; k < 16; ++k) x[k] = buf[a2 + 17 * k];
    dft16<false>(x);
    { const f32x2 w0 = opq(T.w2); f32x2 w = w0;
#pragma unroll
      for (int k = 1; k < 16; ++k) { x[k] = cmul(x[k], w); w = cmul(w, w0); } }
#pragma unroll
    for (int k = 0; k < 16; ++k) buf[a2 + 17 * k] = x[k];
    hbar(hb, lane);
#pragma unroll
    for (int k = 0; k < 16; ++k) x[k] = buf[17 * p + k];
    dft16<false>(x);
}
__device__ __forceinline__ void hy_inv(f32x2 (&x)[16], LAS f32x2* buf, int p, const HyTw& T, HBar& hb, int lane) {
    dft16<true>(x);
    { const f32x2 w0 = opq(T.w2); f32x2 w = w0;
#pragma unroll
      for (int k = 1; k < 16; ++k) { x[k] = cmulc(x[k], w); w = cmul(w, w0); } }
#pragma unroll
    for (int k = 0; k < 16; ++k) buf[17 * p + k] = x[k];
    hbar(hb, lane);
    const int a2 = 272 * (p >> 4) + (p & 15);
#pragma unroll
    for (int k = 0; k < 16; ++k) x[k] = buf[a2 + 17 * k];
    dft16<true>(x);
    { f32x2 w = opq(T.w3); const f32x2 w4 = opq(T.w4);
#pragma unroll
      for (int k = 0; k < 16; ++k) { x[k] = cmulc(x[k], w); w = cmul(w, w4); } }
#pragma unroll
    for (int k = 0; k < 16; ++k) buf[a2 + 17 * k] = x[k];
    hbar(hb, lane);
    const int a1 = p + (p >> 4);
#pragma unroll
    for (int k = 0; k < 16; ++k) x[k] = buf[272 * k + a1];
    dft16<true>(x);
}
constexpr int HY_BUF0 = 0, HY_BUF1 = 34816, HY_PU = 69632, HY_PG = 102400, HY_RED = 135168;
#define HY_W32 ((f32x2){0.9807852804032304f, -0.19509032201612825f})
__device__ __forceinline__ void hy_stage_short(Frame& F, LAS f32x2* dst, const bf16* row, int bp, float w0, float w1, float w2, float bs) {
    const int n0 = 8 * F.tid;
    float o[2][8];
#pragma unroll
    for (int s2 = 0; s2 < 2; ++s2) { const bf16* r = row + (size_t)(2 * bp + s2) * SEQ + n0;
        const u32x4 ch = *(const u32x4*)r;
        const float lft = (n0 > 0) ? bf2f(r[-1]) : 0.f, rgt = (n0 + 8 < SEQ) ? bf2f(r[8]) : 0.f;
        float z[10]; z[0] = lft; z[9] = rgt;
        z[1] = __uint_as_float(ch.x << 16); z[2] = __uint_as_float(ch.x & 0xffff0000u); z[3] = __uint_as_float(ch.y << 16); z[4] = __uint_as_float(ch.y & 0xffff0000u);
        z[5] = __uint_as_float(ch.z << 16); z[6] = __uint_as_float(ch.z & 0xffff0000u); z[7] = __uint_as_float(ch.w << 16); z[8] = __uint_as_float(ch.w & 0xffff0000u);
#pragma unroll
        for (int e = 0; e < 8; ++e) o[s2][e] = w0 * z[e] + w1 * z[e + 1] + w2 * z[e + 2] + bs; }
#pragma unroll
    for (int e = 0; e < 8; e += 2) *(LAS f32x4*)(dst + n0 + e) = (f32x4){o[0][e], o[1][e], o[0][e + 1], o[1][e + 1]};
}
__device__ __forceinline__ void hyena_task(Frame& F, int c) {
    const int tid = F.tid, hs = tid >> 8; int p = tid & 255;
    asm volatile("" : "+v"(p));
    LAS f32x2* buf = (LAS f32x2*)(F.lds + (hs ? HY_BUF1 : HY_BUF0));
    LAS f32x2* buf1 = (LAS f32x2*)(F.lds + HY_BUF1);
    LAS f32x2* PU = (LAS f32x2*)(F.lds + HY_PU); LAS f32x2* PG = (LAS f32x2*)(F.lds + HY_PG);
    LAS float* red = (LAS float*)(F.lds + HY_RED);
    const bf16* HYT = (const bf16*)(F.ws + WS_HYT); const float* KT = (const float*)(F.ws + WS_KT); bf16* YT = (bf16*)(F.ws + WS_YT) + (size_t)c * NT;
    HBar hb; hb.cnt = (LAS unsigned*)(F.lds + HY_RED + 64) + hs; hb.target = 0u;
    __syncthreads();
    if (tid < 2) ((LAS unsigned*)(F.lds + HY_RED + 64))[tid] = 0u;
    __syncthreads();
    f32x2* Y0 = (f32x2*)(F.ws + WS_H2) + (size_t)c * 2 * SEQ;
    HyTw T;
    { float sn, cs; sincosf((float)p * (6.283185307179586f / 4096.0f), &sn, &cs); T.w1 = (f32x2){cs, -sn};
      sincosf((float)(p & 15) * (6.283185307179586f / 256.0f), &sn, &cs); T.w2 = (f32x2){cs, -sn};
      sincosf((float)((p & 15) * (p >> 4)) * (6.283185307179586f / 4096.0f), &sn, &cs); T.w3 = (f32x2){cs, -sn};
      sincosf((float)(p >> 4) * (6.283185307179586f / 256.0f), &sn, &cs); T.w4 = (f32x2){cs, -sn};
      sincosf((float)p * (6.283185307179586f / 8192.0f), &sn, &cs); T.w8 = (f32x2){cs, -sn}; }
    const float* SW = F.in[8]; const float* SB = F.in[9];
#pragma unroll
    for (int o = 0; o < 2; ++o) {
        const int ucol = c, gcol = (o == 0 ? 512 : 1024) + c;
        const float uw0 = SW[ucol], uw1 = SW[1536 + ucol], uw2 = SW[3072 + ucol], ubs = SB[ucol];
        const float gw0 = SW[gcol], gw1 = SW[1536 + gcol], gw2 = SW[3072 + gcol], gbs = SB[gcol];
        const float skip = F.in[16][o * 512 + c];
        f32x2 x[16], Kh[16];
        asm volatile("" : "+v"(p));
        { const float* kf = KT + ((size_t)(o * 2 + 0) * 512 + c) * 4096; const float* kb = KT + ((size_t)(o * 2 + 1) * 512 + c) * 4096;
          float l1 = 0.f; f32x2 w = opq(T.w8);
#pragma unroll
          for (int q = 0; q < 16; ++q) { const int n = p + 256 * q; const float f = kf[n]; const float bk = (n >= 1) ? kb[4096 - n] : 0.f; l1 += fabsf(f) + fabsf(bk);
              if (hs == 0) x[q] = (f32x2){f + bk, 0.f}; else { const float dlt = f - bk; x[q] = (f32x2){dlt * w.x, dlt * w.y}; }
              w = cmul(w, HY_W32); }
          l1 = wave_sum(l1);
          __syncthreads();
          if (F.lane == 0) red[F.wave] = l1;
          hy_fwd(x, buf, p, T, hb, F.lane);
          const float tot = red[4 * hs] + red[4 * hs + 1] + red[4 * hs + 2] + red[4 * hs + 3];
          const float scl = 1.0f / ((tot + EPS) * 8192.0f);
#pragma unroll
          for (int k = 0; k < 16; ++k) Kh[k] = x[k] * scl; }
#pragma unroll 1
        for (int bp = 0; bp < 2; ++bp) {
            asm volatile("" : "+v"(p));
            __syncthreads();
            if (o == 0) hy_stage_short(F, PU, HYT + (size_t)ucol * NT, bp, uw0, uw1, uw2, ubs);
            else { const f32x4* src = (const f32x4*)(Y0 + (size_t)bp * SEQ + 8 * tid);
#pragma unroll
                for (int e = 0; e < 4; ++e) *(LAS f32x4*)(PU + 8 * tid + 2 * e) = src[e]; }
            hy_stage_short(F, PG, HYT + (size_t)gcol * NT, bp, gw0, gw1, gw2, gbs);
            __syncthreads();
            asm volatile("" : "+v"(p));
            { f32x2 w = opq(T.w8);
#pragma unroll
              for (int q = 0; q < 16; ++q) { const f32x2 u = PU[p + 256 * q]; x[q] = (hs == 0) ? u : cmul(u, w); w = cmul(w, HY_W32); } }
            hy_fwd(x, buf, p, T, hb, F.lane);
#pragma unroll
            for (int k = 0; k < 16; ++k) x[k] = cmul(x[k], Kh[k]);
            hy_inv(x, buf, p, T, hb, F.lane);
            asm volatile("" : "+v"(p));
            if (hs == 1) { f32x2 w = opq(T.w8);
#pragma unroll
                for (int q = 0; q < 16; ++q) { const int n = p + 256 * q; buf1[n + (n >> 4)] = cmulc(x[q], w); w = cmul(w, HY_W32); }
            }
            __syncthreads();
            asm volatile("" : "+v"(p));
            if (hs == 0) {
#pragma unroll
                for (int q = 0; q < 16; ++q) { const int n = p + 256 * q; const f32x2 conv = x[q] + buf1[n + (n >> 4)];
                    const f32x2 yv = (conv + PU[n] * skip) * PG[n];
                    if (o == 0) Y0[(size_t)bp * SEQ + n] = yv;
                    else { YT[(size_t)(2 * bp) * SEQ + n] = (bf16)(pk2(yv.x, 0.f) & 0xffffu); YT[(size_t)(2 * bp + 1) * SEQ + n] = (bf16)(pk2(yv.y, 0.f) & 0xffffu); } }
                if (o == 0) asm volatile("s_waitcnt vmcnt(0)" ::: "memory");
            }
        }
    }
    __syncthreads();
}

__device__ __forceinline__ void yt_transpose(Frame& F) {
    const bf16* YT = (const bf16*)(F.ws + WS_YT); bf16* YC = (bf16*)(F.ws + WS_YCAT);
    LAS bf16* til = (LAS bf16*)(F.lds + F.wave * 8448);
    const int lane = F.lane;
    __syncthreads();
    for (int it = F.bid * NWAVES + F.wave; it < 8 * 256; it += F.G * NWAVES) {
        const int c0 = (it & 7) * 64, t0 = (it >> 3) * 64;
        u32x4 v[8];
#pragma unroll
        for (int i = 0; i < 8; ++i) { const int cr = 8 * i + (lane >> 3), ck = lane & 7; v[i] = *(const u32x4*)(YT + (size_t)(c0 + cr) * NT + t0 + 8 * ck); }
#pragma unroll
        for (int i = 0; i < 8; ++i) { const int cr = 8 * i + (lane >> 3), ck = lane & 7; LAS unsigned* d = (LAS unsigned*)(til + cr * 66 + 8 * ck); d[0] = v[i].x; d[1] = v[i].y; d[2] = v[i].z; d[3] = v[i].w; }
        LDS_WAIT(); asm volatile("" ::: "memory");
#pragma unroll
        for (int i = 0; i < 8; ++i) { const int tr = 8 * i + (lane >> 3), ck = lane & 7;
            const LAS bf16* sp = til + (8 * ck) * 66 + tr;
            u32x4 o; o.x = (unsigned)sp[0] | ((unsigned)sp[66] << 16); o.y = (unsigned)sp[2 * 66] | ((unsigned)sp[3 * 66] << 16); o.z = (unsigned)sp[4 * 66] | ((unsigned)sp[5 * 66] << 16); o.w = (unsigned)sp[6 * 66] | ((unsigned)sp[7 * 66] << 16);
            *(u32x4*)(YC + (size_t)(t0 + tr) * 1024 + c0 + 8 * ck) = o; }
        LDS_WAIT(); asm volatile("" ::: "memory");
    }
}

__device__ __forceinline__ void seqfft_phase(Frame& F) {
    const int tid = F.tid, hs = tid >> 8; int p = tid & 255;
    asm volatile("" : "+v"(p));
    LAS f32x2* buf = (LAS f32x2*)(F.lds + (hs ? HY_BUF1 : HY_BUF0));
    LAS bf16* stg = (LAS bf16*)(F.lds + 69632);
    LAS bf16* stgI = (LAS bf16*)(F.lds + 69632 + 65536 + 256);
    const bf16* PQ = (const bf16*)(F.ws + WS_PQT); bf16* Y = (bf16*)(F.ws + WS_Y);
    HBar hb; hb.cnt = (LAS unsigned*)(F.lds + 69632 + 65536 + 64) + hs; hb.target = 0u;
    __syncthreads();
    if (tid < 2) ((LAS unsigned*)(F.lds + 69632 + 65536 + 64))[tid] = 0u;
    __syncthreads();
    HyTw T;
    { float sn, cs; sincosf((float)p * (6.283185307179586f / 4096.0f), &sn, &cs); T.w1 = (f32x2){cs, -sn};
      sincosf((float)(p & 15) * (6.283185307179586f / 256.0f), &sn, &cs); T.w2 = (f32x2){cs, -sn};
      T.w3 = T.w1; T.w4 = T.w2; T.w8 = T.w1; }
    for (int task = F.bid; task < 256; task += F.G) {
        const int bg = (task & 7) + 8 * (task >> 7), m = (task >> 3) & 15, b = bg >> 2, g = bg & 3;
        const bf16* base = PQ + (size_t)bg * 256 * 4096;
        unsigned short rp[16], rq[16];
        { const int k = 8 * m + 1 + hs; const bf16* Pr = base + (size_t)k * 4096 + p; const bf16* Qr = base + (size_t)(k < 128 ? 128 + k : 0) * 4096 + p;
#pragma unroll
          for (int q = 0; q < 16; ++q) { rp[q] = Pr[256 * q]; rq[q] = Qr[256 * q]; } }
#pragma unroll 1
        for (int s = 0; s < 4; ++s) {
            asm volatile("" : "+v"(p));
            const int j = 2 * s + hs, k = 8 * m + 1 + j;
            const float qs = (k < 128) ? -1.0f : 1.0f;
            f32x2 x[16];
#pragma unroll
            for (int q = 0; q < 16; ++q) x[q] = (f32x2){bf2f(rp[q]), qs * bf2f(rq[q])};
            if (s < 3) { const int kn = k + 2; const bf16* Pr = base + (size_t)kn * 4096 + p; const bf16* Qr = base + (size_t)(kn < 128 ? 128 + kn : 0) * 4096 + p;
#pragma unroll
                for (int q = 0; q < 16; ++q) { rp[q] = Pr[256 * q]; rq[q] = Qr[256 * q]; } }
            hy_fwd(x, buf, p, T, hb, F.lane);
#pragma unroll
            for (int k2 = 0; k2 < 16; ++k2) stg[(k2 * 256 + p) * 8 + j] = (bf16)(pk2(x[k2].x * (1.0f / 64.0f), 0.f) & 0xffffu);
            if (k == 128) {
#pragma unroll
                for (int k2 = 0; k2 < 16; ++k2) stgI[k2 * 256 + p] = (bf16)(pk2(x[k2].y * (1.0f / 64.0f), 0.f) & 0xffffu); }
        }
        __syncthreads();
#pragma unroll 2
        for (int jj = 0; jj < 8; ++jj) { const int e = tid + 512 * jj, f = ((e & 255) >> 4) + 16 * (e & 15) + 256 * (e >> 8);
            const int fm = (4096 - f) & 4095, em = (fm >> 8) * 256 + (fm & 15) * 16 + ((fm >> 4) & 15);
            u32x4 d = *(const LAS u32x4*)(stg + e * 8), dm = *(const LAS u32x4*)(stg + em * 8);
            bf16* yr = Y + ((size_t)(b * SEQ + f)) * 1024 + g * 256;
            if (m == 15) {
                const float c128 = 0.5f * (__uint_as_float(d.w & 0xffff0000u) + __uint_as_float(dm.w & 0xffff0000u));
                const unsigned h = pk2(c128, 0.f) & 0xffffu; d.w = (d.w & 0xffffu) | (h << 16); dm.w = (dm.w & 0xffffu) | (h << 16);
                yr[0] = (bf16)(pk2(0.5f * (bf2f(stgI[e]) + bf2f(stgI[em])), 0.f) & 0xffffu); }
            yr[8 * m + 1] = (bf16)(d.x & 0xffffu);
            *(unsigned*)(yr + 8 * m + 2) = (d.x >> 16) | (d.y << 16);
            { u32x2 w; w.x = (d.y >> 16) | (d.z << 16); w.y = (d.z >> 16) | (d.w << 16); *(u32x2*)(yr + 8 * m + 4) = w; }
            yr[8 * m + 8] = (bf16)(d.w >> 16);
            { u32x4 r; r.x = (dm.w >> 16) | (dm.w << 16); r.y = (dm.z >> 16) | (dm.z << 16); r.z = (dm.y >> 16) | (dm.y << 16); r.w = (dm.x >> 16) | (dm.x << 16);
              *(u32x4*)(yr + 248 - 8 * m) = r; } }
        __syncthreads();
    }
}

__device__ __forceinline__ void route_phase(Frame& F, const bf16* X, const float* g, const float* mod) {
    LAS float* gs = (LAS float*)(F.lds);
    LAS float* sv = (LAS float*)(F.lds + 16384);
    LAS unsigned char* stage = F.lds + 32768;
    LAS unsigned* rinfo = (LAS unsigned*)(F.lds + 98304);
    LAS unsigned* lcnt = (LAS unsigned*)(F.lds + 100352);
    for (int i = F.tid; i < 4 * 1024; i += NTHR) { const int b = i >> 10, k = i & 1023; gs[i] = g[k] * (1.0f + mod[(size_t)b * NMOD + 4 * D + k]); sv[i] = mod[(size_t)b * NMOD + 3 * D + k]; }
    __syncthreads();
    const float* WR = F.in[23]; const float* BR = F.in[24];
    unsigned char* ACS = F.ws + WS_ACS; unsigned* ctl = (unsigned*)(F.ws + WS_CTL); unsigned* RT = (unsigned*)(F.ws + WS_ROUTE);
    for (int blk = F.bid; blk < NT / 64; blk += F.G) {
        if (F.tid < 8) lcnt[F.tid] = 0u;
        __syncthreads();
#pragma unroll 1
        for (int rw = 0; rw < 8; ++rw) {
            const int rl = F.wave * 8 + rw, row = blk * 64 + rl;
            const int b = row >> 12; const bf16* xr = X + (size_t)row * D;
            f32x4 v[4]; float s = 0.f;
#pragma unroll
            for (int j = 0; j < 4; ++j) { const u32x2 q = *((const u32x2*)xr + F.lane + 64 * j); v[j] = (f32x4){__uint_as_float(q.x << 16), __uint_as_float(q.x & 0xffff0000u), __uint_as_float(q.y << 16), __uint_as_float(q.y & 0xffff0000u)};
                s += (v[j].x * v[j].x + v[j].y * v[j].y) + (v[j].z * v[j].z + v[j].w * v[j].w); }
            const float rstd = 1.0f / sqrtf(wave_sum(s) * (1.0f / D) + EPS);
            float lg[8];
#pragma unroll
            for (int e = 0; e < 8; ++e) lg[e] = 0.f;
#pragma unroll
            for (int j = 0; j < 4; ++j) { const int k = 4 * F.lane + 256 * j; const f32x4 a = *(const LAS f32x4*)(gs + b * 1024 + k), c = *(const LAS f32x4*)(sv + b * 1024 + k);
                const f32x4 o = v[j] * rstd * a + c;
                *(LAS unsigned*)(stage + rl * 1024 + k) = pg8::pk4_fp8(o.x * H8_SCALE, o.y * H8_SCALE, o.z * H8_SCALE, o.w * H8_SCALE);
#pragma unroll
                for (int q = 0; q < 4; ++q) { const f32x4 w0 = *(const f32x4*)(WR + (size_t)(k + q) * 8), w1 = *(const f32x4*)(WR + (size_t)(k + q) * 8 + 4);
                    lg[0] += o[q] * w0.x; lg[1] += o[q] * w0.y; lg[2] += o[q] * w0.z; lg[3] += o[q] * w0.w; lg[4] += o[q] * w1.x; lg[5] += o[q] * w1.y; lg[6] += o[q] * w1.z; lg[7] += o[q] * w1.w; } }
#pragma unroll
            for (int e = 0; e < 8; ++e) lg[e] = wave_sum(lg[e]) + BR[e];
            int ea = 0; float va = lg[0];
#pragma unroll
            for (int e = 1; e < 8; ++e) if (lg[e] > va) { va = lg[e]; ea = e; }
            int eb = -1; float vb = -3.0e38f;
#pragma unroll
            for (int e = 0; e < 8; ++e) if (e != ea && lg[e] > vb) { vb = lg[e]; eb = e; }
            const float pb = __expf(vb - va), wa = 1.0f / (1.0f + pb), wb = pb * wa;
            if (F.lane == 0) { const unsigned la = __hip_atomic_fetch_add(lcnt + ea, 1u, __ATOMIC_RELAXED, __HIP_MEMORY_SCOPE_WORKGROUP), lb = __hip_atomic_fetch_add(lcnt + eb, 1u, __ATOMIC_RELAXED, __HIP_MEMORY_SCOPE_WORKGROUP);
                LAS unsigned* ri = rinfo + rl * 8; ri[0] = (unsigned)ea; ri[1] = (unsigned)eb; ri[2] = __float_as_uint(wa); ri[3] = __float_as_uint(wb); ri[4] = la; ri[5] = lb; }
        }
        __syncthreads();
        if (F.tid < 8) lcnt[8 + F.tid] = xb_add(ctl + CW_CNT + 64 * F.tid, lcnt[F.tid]);
        __syncthreads();
#pragma unroll 1
        for (int rw = 0; rw < 8; ++rw) {
            const int rl = F.wave * 8 + rw, row = blk * 64 + rl;
            const LAS unsigned* ri = rinfo + rl * 8;
            const unsigned ea = ri[0], eb = ri[1], sa = lcnt[8 + ea] + ri[4], sb = lcnt[8 + eb] + ri[5];
            const u32x4 d = *(const LAS u32x4*)(stage + rl * 1024 + 16 * F.lane);
            *((u32x4*)(ACS + ((size_t)ea * NT + sa) * D) + F.lane) = d; *((u32x4*)(ACS + ((size_t)eb * NT + sb) * D) + F.lane) = d;
            if (F.lane == 0) { u32x4 r; r.x = (ea << 24) | sa; r.y = (eb << 24) | sb; r.z = ri[2]; r.w = ri[3]; *(u32x4*)(RT + (size_t)row * 4) = r; }
        }
        __syncthreads();
    }
}
__device__ __forceinline__ void moe_tiles(Frame& F, int (&tb)[9]) {
    unsigned* ctl = (unsigned*)(F.ws + WS_CTL); int acc = 0;
#pragma unroll
    for (int e = 0; e < 8; ++e) { tb[e] = acc; acc += ((int)xb_ld(ctl + CW_CNT + 64 * e) + 255) >> 8; }
    tb[8] = acc;
}
__device__ __forceinline__ void final_phase(Frame& F, const float* mod) {
    int tb[9]; moe_tiles(F, tb);
    const bf16* SL = (const bf16*)(F.ws + WS_ACOMP); const unsigned* RT = (const unsigned*)(F.ws + WS_ROUTE); const float* fg = F.in[28];
    const int gw = F.bid * NWAVES + F.wave, NGW = F.G * NWAVES;
    for (int row = gw; row < NT; row += NGW) {
        const int b = row >> 12; float* xr = F.out + (size_t)row * D; const bf16* xb = (const bf16*)(F.ws + WS_RB) + (size_t)row * D; const float* gt = mod + (size_t)b * NMOD + 5 * D;
        const u32x4 r = *(const u32x4*)(RT + (size_t)row * 4); const float wa = __uint_as_float(r.z), wb = __uint_as_float(r.w);
        const int ea = r.x >> 24, eb = r.y >> 24; int ba = 0, bb = 0;
#pragma unroll
        for (int e = 0; e < 8; ++e) { ba = (e == ea) ? tb[e] : ba; bb = (e == eb) ? tb[e] : bb; }
        const bf16* sa = SL + ((size_t)ba * 256 + (r.x & 0xffffffu)) * D; const bf16* sb = SL + ((size_t)bb * 256 + (r.y & 0xffffffu)) * D;
        f32x4 v[4]; float s = 0.f;
#pragma unroll
        for (int j = 0; j < 4; ++j) { const int k = 4 * F.lane + 256 * j; const u32x2 xq = *(const u32x2*)(xb + k); const f32x4 gv = *(const f32x4*)(gt + k);
            const f32x4 xv = (f32x4){__uint_as_float(xq.x << 16), __uint_as_float(xq.x & 0xffff0000u), __uint_as_float(xq.y << 16), __uint_as_float(xq.y & 0xffff0000u)};
            const u32x2 ua = *(const u32x2*)(sa + k), ub = *(const u32x2*)(sb + k);
            f32x4 ma, mb; ma.x = __uint_as_float(ua.x << 16); ma.y = __uint_as_float(ua.x & 0xffff0000u); ma.z = __uint_as_float(ua.y << 16); ma.w = __uint_as_float(ua.y & 0xffff0000u);
            mb.x = __uint_as_float(ub.x << 16); mb.y = __uint_as_float(ub.x & 0xffff0000u); mb.z = __uint_as_float(ub.y << 16); mb.w = __uint_as_float(ub.y & 0xffff0000u);
            v[j] = xv + gv * (ma * wa + mb * wb); s += (v[j].x * v[j].x + v[j].y * v[j].y) + (v[j].z * v[j].z + v[j].w * v[j].w); }
        const float rstd = 1.0f / sqrtf(wave_sum(s) * (1.0f / D) + EPS);
#pragma unroll
        for (int j = 0; j < 4; ++j) { const int k = 4 * F.lane + 256 * j; *(f32x4*)(xr + k) = v[j] * rstd * *(const f32x4*)(fg + k); }
    }
}
constexpr int NPHASE = 18;
struct Args { const float* in[29]; float* out; unsigned char* ws; int ph_lo, ph_hi; };
__global__ void __launch_bounds__(NTHR, 2) mk_fwd(Args args) {
    extern __shared__ __attribute__((aligned(16))) unsigned char lds_raw[];
    Frame F;
    F.lds = (LAS unsigned char*)lds_raw;
    F.tid = threadIdx.x; F.lane = F.tid & 63; F.wave = __builtin_amdgcn_readfirstlane(F.tid >> 6);
    F.G = gridDim.x; F.bid = blockIdx.x; F.out = args.out; F.ws = args.ws; F.in = args.in;
    volatile LAS unsigned* MISC = (volatile LAS unsigned*)(F.lds + MISC_OFF);
    if (F.tid < 32) MISC[F.tid] = 0u;
    __syncthreads();
    unsigned* ctl = (unsigned*)(F.ws + WS_CTL);
    XcdBarrier bar; bar.bar = ctl + CW_BAR; bar.x = 0; bar.st = nullptr;
    const int lo = args.ph_lo, hi = args.ph_hi;
    if (hi - lo > 1) bar = xcd_barrier_post(ctl + CW_BAR, MISC + 8);
#ifndef PH_MASK
#define PH_MASK 0x3ffff
#endif
#define IN(k) (((PH_MASK >> (k)) & 1) && lo <= (k) && (k) < hi)
#define SEAM(k) do { if (IN(k) && IN((k) + 1)) xcd_barrier(bar); } while (0)
    const float* MOD0 = (const float*)(F.ws + WS_MOD); const float* MOD1 = MOD0 + 5 * NMOD;
    unsigned char* ws = F.ws;
    bf16* RB = (bf16*)(ws + WS_RB); u64* SS0 = (u64*)(ctl + CW_SS); u64* SS1 = SS0 + NT;

    if (IN(0)) { p0_prologue(F); } SEAM(0);
    if (IN(1)) { norm_phase(F, F.in[0], NT, (bf16*)(ws + WS_H), F.in[2], NCTX, (bf16*)(ws + WS_HC), F.in[6], MOD0, 0, 1); shift_gemvs(F, MOD0, MOD1); } SEAM(1);
    if (IN(2)) { pg8::Gemm g{D, D, D}; SchedIn S{F.G, F.bid, ws}; pg8::EpiBf16 E{1.0f}; pg8::gemm_phase<pg8::EpiBf16, SchedIn>(F.lds, g, S, E);
        moe_tail_convert(F, 784, CV_ITEMS - MOE_DEFER_P2 - MOE_DEFER_P6, CV_ITEMS - MOE_DEFER_P6); } SEAM(2);
    if (IN(3)) {
        for (int c = F.bid; c < CH; c += F.G) hyena_task(F, c);
    } SEAM(3);
    if (IN(4)) {
        for (int t = F.bid; t < 256; t += F.G) na_task(F, t);
        yt_transpose(F);
    } SEAM(4);
    if (IN(5)) { pg8::Gemm g{D, D, D}; SchedPlain S{F.G, F.bid, 64, 4, (const char*)(ws + WS_YCAT), (const char*)(ws + WS_WMIX), nullptr, D, D, 0, 0, 0};
        EpiResN<true, true> E{F.in[0], nullptr, RB, (bf16*)(ws + WS_H), MOD0 + 2 * D, F.in[6] + D, MOD0 + 4 * D, SS0}; pg8::gemm_phase<EpiResN<true, true>, SchedPlain>(F.lds, g, S, E); } SEAM(5);
    if (IN(7)) { pg8::Gemm g{D, D, D}; SchedPlain S{F.G, F.bid, 64, 22, (const char*)(ws + WS_H), (const char*)(ws + WS_WUP), (char*)(ws + WS_ACT), D, D, DFF, 128, 2};
        LAS float* rsl = (LAS float*)(F.lds + RING_BYTES);
        for (int i = 0; ; ++i) { pg8::Unit u; if (!S.next(i, u)) break; if (F.tid < 256) rsl[i * 256 + F.tid] = 1.0f / sqrtf(ld_ss(SS0 + u.row0 + F.tid) * (1.0f / D) + EPS); }
        __syncthreads();
        EpiSwiGLUN E{rsl, (const float*)(ws + WS_SHW)}; pg8::gemm_phase<EpiSwiGLUN, SchedPlain>(F.lds, g, S, E);
        moe_tail_convert(F, 64 * 22, CV_ITEMS - MOE_DEFER_P6, CV_ITEMS); } SEAM(7);
    if (IN(8)) { pg8::Gemm g{DFF, DFF, DFF}; SchedPlain S{F.G, F.bid, 64, 4, (const char*)(ws + WS_ACT), (const char*)(ws + WS_WDN), nullptr, DFF, DFF, 0, 0, 0};
        EpiResN<false, true> E{nullptr, RB, RB, (bf16*)(ws + WS_H), MOD0 + 5 * D, F.in[6] + 2 * D, MOD1 + 1 * D, SS1}; pg8::gemm_phase<EpiResN<false, true>, SchedPlain>(F.lds, g, S, E); } SEAM(8);
    if (IN(10)) { pg8::Gemm g{256, D, 256}; SchedChDft S{F.G, F.bid, ws};     LAS float* rsl = (LAS float*)(F.lds + RING_BYTES);
        for (int i = 0; ; ++i) { pg8::Unit u; if (!S.next(i, u)) break; if (F.tid < 256) rsl[i * 256 + F.tid] = 1.0f / sqrtf(ld_ss(SS1 + u.col0 + F.tid) * (1.0f / D) + EPS); }
        __syncthreads();
        EpiDftN E{rsl, (const float*)(ws + WS_DSH)}; pg8::gemm_phase<EpiDftN, SchedChDft>(F.lds, g, S, E); } SEAM(10);
    if (IN(11)) { seqfft_phase(F); } SEAM(11);
    if (IN(12)) { pg8::Gemm g{D, D, D}; SchedPlain S{F.G, F.bid, 64, 4, (const char*)(ws + WS_Y), (const char*)(ws + WS_WFOU), nullptr, D, D, 0, 0, 0};
        EpiResN<false, false> E{nullptr, RB, RB, nullptr, MOD1 + 2 * D, nullptr, nullptr, nullptr}; pg8::gemm_phase<EpiResN<false, false>, SchedPlain>(F.lds, g, S, E); } SEAM(12);
    if (IN(13)) { route_phase(F, RB, F.in[6] + 3 * D, MOD1); } SEAM(13);
    if (IN(15)) { pg8::Gemm g{D / 2, D / 2, D / 2}; SchedMoe S; S.G = F.G; S.c = F.bid; S.nN = 28; moe_tiles(F, S.tb); S.A = (const char*)(ws + WS_ACS); S.B = (const char*)(ws + WS_MOEUP); S.O = (char*)(ws + WS_MACT); S.sparseA = 1;
        S.lda = D / 2; S.ldb = D / 2; S.ldc = DFE / 2; S.ocol = 64; S.bstride = (size_t)2 * DFE * D;
        pg8::EpiSwiGLU8 E{1.0f / (H8_SCALE * W8_SCALE), A8_SCALE}; pg8::gemm_phase<pg8::EpiSwiGLU8, SchedMoe>(F.lds, g, S, E); } SEAM(15);
    if (IN(16)) { pg8::Gemm g{DFE / 2, DFE / 2, DFE / 2}; SchedMoe S; S.G = F.G; S.c = F.bid; S.nN = 4; moe_tiles(F, S.tb); S.A = (const char*)(ws + WS_MACT); S.B = (const char*)(ws + WS_MOEDN); S.O = (char*)(ws + WS_ACOMP); S.sparseA = 0;
        S.lda = DFE / 2; S.ldb = DFE / 2; S.ldc = D; S.ocol = 256; S.bstride = (size_t)D * DFE;
        pg8::EpiBf16F8 E{1.0f / (A8_SCALE * W8_SCALE)}; pg8::gemm_phase<pg8::EpiBf16F8, SchedMoe>(F.lds, g, S, E); } SEAM(16);
    if (IN(17)) { final_phase(F, MOD1); }
#undef IN
#undef SEAM
}

extern "C" void kernel_launch(void* const* d_in, const int* in_sizes, int n_in, void* d_out, int out_size, void* d_ws, size_t ws_size, hipStream_t stream) {
    static int grid = 0;
    if (grid == 0) {
        if (n_in != 29 || in_sizes[0] != NT * D || out_size != NT * D || ws_size < WS_END) { fprintf(stderr, "kernel_launch: unexpected problem (n_in %d, in0 %d, out %d, ws %zu < %zu); nothing launched\n", n_in, n_in > 0 ? in_sizes[0] : -1, out_size, ws_size, (size_t)WS_END); grid = -1; return; }
        int dev = 0, cus = 0, per_cu = 0;
        if (hipGetDevice(&dev) != hipSuccess || hipDeviceGetAttribute(&cus, hipDeviceAttributeMultiprocessorCount, dev) != hipSuccess) { grid = -1; return; }
        if (hipFuncSetAttribute((const void*)mk_fwd, hipFuncAttributeMaxDynamicSharedMemorySize, LDS_BYTES) != hipSuccess) { fprintf(stderr, "kernel_launch: hipFuncSetAttribute failed\n"); grid = -1; return; }
        if (hipOccupancyMaxActiveBlocksPerMultiprocessor(&per_cu, (const void*)mk_fwd, NTHR, LDS_BYTES) != hipSuccess || per_cu < 1) fprintf(stderr, "kernel_launch: occupancy query reports %d\n", per_cu);
        (void)hipGetLastError();
        grid = cus;
    }
    if (grid < 0) return;
    if (hipMemsetAsync((char*)d_ws + WS_CTL, 0, CTL_ZERO_BYTES, stream) != hipSuccess) return;
    Args a{};
    for (int i = 0; i < 29; ++i) a.in[i] = (const float*)d_in[i];
    a.out = (float*)d_out; a.ws = (unsigned char*)d_ws;
#if MK_PER_PHASE
    for (int ph = 0; ph < NPHASE; ++ph) { a.ph_lo = ph; a.ph_hi = ph + 1; hipLaunchKernelGGL(mk_fwd, dim3(grid), dim3(NTHR), LDS_BYTES, stream, a); }
#else
    a.ph_lo = 0; a.ph_hi = NPHASE; hipLaunchKernelGGL(mk_fwd, dim3(grid), dim3(NTHR), LDS_BYTES, stream, a);
#endif
}
```

```cpp
#include <hip/hip_runtime.h>
#include <cstdio>
#include <cstdint>

#ifndef MK_PER_PHASE
#define MK_PER_PHASE 0
#endif

#define LAS __attribute__((address_space(3)))
typedef unsigned short bf16;
typedef short bf16x8 __attribute__((ext_vector_type(8)));
typedef float f32x4 __attribute__((ext_vector_type(4)));
typedef float f32x2 __attribute__((ext_vector_type(2)));
typedef unsigned u32x4 __attribute__((ext_vector_type(4)));
typedef unsigned u32x2 __attribute__((ext_vector_type(2)));

#define XB_TMO      128
#define XB_XCNT(j)  (256  + 64 * (j))
#define XB_XSUB(j)  (1280 + 64 * (j))
#define XB_XGEN(j)  (2304 + 64 * (j))
#define XB_TOP      3328
#define XB_TOPGEN   3392
#define XCD_BAR_WORDS 3456
#define XB_SPIN_CAP (1u << 18)

__device__ __forceinline__ unsigned xb_ld(unsigned* p)              { return __hip_atomic_load(p, __ATOMIC_RELAXED, __HIP_MEMORY_SCOPE_AGENT); }
__device__ __forceinline__ unsigned xb_add(unsigned* p, unsigned v) { return __hip_atomic_fetch_add(p, v, __ATOMIC_RELAXED, __HIP_MEMORY_SCOPE_AGENT); }
__device__ __forceinline__ unsigned xb_xcc_id() { return (unsigned)__builtin_amdgcn_s_getreg((3 << 11) | 20) & 0xFu; }
#define XB_SPIN(cond, bar) do { unsigned _sp = 0; while (cond) { __builtin_amdgcn_s_sleep(1); \
    if ((++_sp & 255u) == 0u) { if (xb_ld(&(bar)[XB_TMO])) break; if (_sp > XB_SPIN_CAP) { atomicAdd(&(bar)[XB_TMO], 1u); break; } } } } while (0)

struct XcdBarrier { unsigned* bar; unsigned x; volatile LAS unsigned* st; };

__device__ __forceinline__ XcdBarrier xcd_barrier_post(unsigned* bar, volatile LAS unsigned* st) {
    XcdBarrier b; b.bar = bar; b.x = xb_xcc_id(); b.st = st;
    if (threadIdx.x == 0) (void)xb_add(&bar[XB_XCNT(b.x)], 1u);
    return b;
}
__device__ __forceinline__ void xcd_barrier_complete(unsigned* bar, unsigned x, unsigned& nloc, unsigned& nx) {
    const unsigned G = gridDim.x * gridDim.y * gridDim.z;
    unsigned sum, cnt, mine, sp = 0u;
    for (;;) {
        sum = 0u; cnt = 0u; mine = 0u;
#pragma unroll
        for (unsigned j = 0; j < 16; ++j) { const unsigned c = xb_ld(&bar[XB_XCNT(j)]); sum += c; cnt += (c > 0u) ? 1u : 0u; mine = (j == x) ? c : mine; }
        if (sum == G) break;
        __builtin_amdgcn_s_sleep(1);
        if ((++sp & 255u) == 0u) { if (xb_ld(&bar[XB_TMO])) break; if (sp > XB_SPIN_CAP) { atomicAdd(&bar[XB_TMO], 1u); break; } }
    }
    nloc = mine > 0u ? mine : 1u; nx = cnt > 0u ? cnt : 1u;
}
__device__ __forceinline__ void xcd_barrier(const XcdBarrier& b) {
    asm volatile("s_waitcnt vmcnt(0)" ::: "memory");
    __syncthreads();
    if (threadIdx.x == 0) {
        unsigned* bar = b.bar;
        __builtin_amdgcn_s_waitcnt(0);
        unsigned nloc = b.st[0], nx = b.st[1];
        if (nloc == 0u) { xcd_barrier_complete(bar, b.x, nloc, nx); b.st[0] = nloc; b.st[1] = nx; }
        const unsigned old = xb_add(&bar[XB_XSUB(b.x)], 1u);
        const unsigned gen = old / nloc;
        if (old + 1u == (gen + 1u) * nloc) {
            __builtin_amdgcn_fence(__ATOMIC_RELEASE, "agent");
            asm volatile("s_waitcnt vmcnt(0)" ::: "memory");
            const unsigned og = xb_add(&bar[XB_TOP], 1u);
            const unsigned tg = og / nx;
            if (og + 1u == (tg + 1u) * nx) xb_add(&bar[XB_TOPGEN], 1u);
            else XB_SPIN(xb_ld(&bar[XB_TOPGEN]) == tg, bar);
            xb_add(&bar[XB_XGEN(b.x)], 1u);
            __builtin_amdgcn_fence(__ATOMIC_ACQUIRE, "agent");
            asm volatile("s_waitcnt vmcnt(0)" ::: "memory");
        } else {
            __builtin_amdgcn_fence(__ATOMIC_ACQUIRE, "agent");
            asm volatile("s_waitcnt vmcnt(0)" ::: "memory");
            XB_SPIN(xb_ld(&bar[XB_XGEN(b.x)]) == gen, bar);
        }
    }
    __syncthreads();
}

namespace pg8 {
constexpr int BM = 256, BK = 64, HALF = 128, HTB = HALF * BK * 2, STAGE_BYTES = 8 * HTB, NXCD = 8, WGM = 8;
__host__ __device__ __forceinline__ int lds_byte(int r, int c) { const int st = (r >> 4) * 2 + (c >> 5), rr = r & 15, cc = c & 31, ob = rr * 64 + cc * 2; return st * 1024 + (ob ^ (((ob >> 9) & 1) << 5)); }
__host__ __device__ __forceinline__ void stage_rc(int b, int& R, int& C) { const int st = b / 1024, sb = b % 1024, swz = sb ^ (((sb >> 9) & 1) << 5); R = (st >> 1) * 16 + swz / 64; C = (st & 1) * 32 + (swz % 64) / 2; }
__host__ __device__ __forceinline__ int perm32(int rho) { const int n = rho >> 4, i = rho & 15; return 8 * (i >> 2) + 4 * n + (i & 3); }

struct Unit { const char* a; const char* b; char* o; int ldc; int row0; int col0; int aux; };
struct Gemm { int lda, ldb, K; };

__device__ __forceinline__ void grid_unit(int L, int nM, int nN, int& pm, int& pn) {
    const int nwg = nM * nN; int wgid = L;
    { const int q = nwg / NXCD, r = nwg % NXCD, xcd = wgid % NXCD, off = wgid / NXCD; wgid = (xcd < r ? xcd * (q + 1) : r * (q + 1) + (xcd - r) * q) + off; }
    const int nig = WGM * nN, gid = wgid / nig, fm = gid * WGM, gsz = (nM - fm) < WGM ? (nM - fm) : WGM;
    pm = fm + ((wgid % nig) % gsz); pn = (wgid % nig) / gsz;
}

__device__ __forceinline__ unsigned cvt_pk_bf16(float lo, float hi) { unsigned r; asm volatile("v_cvt_pk_bf16_f32 %0, %1, %2" : "=v"(r) : "v"(lo), "v"(hi)); return r; }

struct EpiBf16 {
    static constexpr bool PERM = true, FP8 = false;
    float scale;
    __device__ __forceinline__ void operator()(const f32x4 (&acc)[2][2][4][2], const Unit& u, int wr, int wc, int fr, int fq) const {
        bf16* base = (bf16*)u.o + (size_t)(wr * 64 + fr) * u.ldc + wc * 32 + 8 * fq;
#pragma unroll
        for (int ai = 0; ai < 2; ++ai)
#pragma unroll
            for (int m = 0; m < 4; ++m) { bf16* rowp = base + (size_t)(ai * HALF + m * 16) * u.ldc;
#pragma unroll
                for (int bj = 0; bj < 2; ++bj) { const f32x4 v0 = acc[ai][bj][m][0] * scale, v1 = acc[ai][bj][m][1] * scale;
                    u32x4 w; w.x = cvt_pk_bf16(v0[0], v0[1]); w.y = cvt_pk_bf16(v0[2], v0[3]); w.z = cvt_pk_bf16(v1[0], v1[1]); w.w = cvt_pk_bf16(v1[2], v1[3]);
                    *(u32x4*)(rowp + bj * HALF) = w; } }
    }
};
struct EpiSwiGLU {
    static constexpr bool PERM = true, FP8 = false;
    __device__ __forceinline__ void operator()(const f32x4 (&acc)[2][2][4][2], const Unit& u, int wr, int wc, int fr, int fq) const {
        bf16* base = (bf16*)u.o + (size_t)(wr * 64 + fr) * u.ldc + wc * 32 + 8 * fq;
#pragma unroll
        for (int ai = 0; ai < 2; ++ai)
#pragma unroll
            for (int m = 0; m < 4; ++m) { bf16* rowp = base + (size_t)(ai * HALF + m * 16) * u.ldc;
                float r[8];
#pragma unroll
                for (int n = 0; n < 2; ++n)
#pragma unroll
                    for (int j = 0; j < 4; j += 2) {
                        const f32x2 A = (f32x2){acc[ai][0][m][n][j], acc[ai][0][m][n][j + 1]}, B = (f32x2){acc[ai][1][m][n][j], acc[ai][1][m][n][j + 1]};
                        const f32x2 t = A * (-1.4426950408889634f); f32x2 d; d.x = __builtin_amdgcn_exp2f(t.x); d.y = __builtin_amdgcn_exp2f(t.y); d = d + 1.0f;
                        f32x2 q; q.x = __builtin_amdgcn_rcpf(d.x); q.y = __builtin_amdgcn_rcpf(d.y);
                        const f32x2 o = (A * B) * q; r[n * 4 + j] = o.x; r[n * 4 + j + 1] = o.y; }
                u32x4 w; w.x = cvt_pk_bf16(r[0], r[1]); w.y = cvt_pk_bf16(r[2], r[3]); w.z = cvt_pk_bf16(r[4], r[5]); w.w = cvt_pk_bf16(r[6], r[7]);
                *(u32x4*)rowp = w; }
    }
};
struct EpiResid {
    static constexpr bool PERM = false, FP8 = false;
    const float* R; float* X; const float* gate;
    int gstride;
    __device__ __forceinline__ void operator()(const f32x4 (&acc)[2][2][4][2], const Unit& u, int wr, int wc, int fr, int fq) const {
        const int row0 = u.row0 + wr * 64 + fr, col0 = u.col0 + wc * 32 + 4 * fq;
        const float* gp = gate + (size_t)(u.row0 >> 12) * gstride + col0;
        f32x4 gv[2][2];
#pragma unroll
        for (int bj = 0; bj < 2; ++bj)
#pragma unroll
            for (int n = 0; n < 2; ++n) gv[bj][n] = *(const f32x4*)(gp + bj * HALF + n * 16);
#pragma unroll
        for (int ai = 0; ai < 2; ++ai)
#pragma unroll
            for (int m = 0; m < 4; ++m) { const size_t ro = (size_t)(row0 + ai * HALF + m * 16) * 1024 + col0;
#pragma unroll
                for (int bj = 0; bj < 2; ++bj)
#pragma unroll
                    for (int n = 0; n < 2; ++n) { const f32x4 rv = *(const f32x4*)(R + ro + bj * HALF + n * 16); *(f32x4*)(X + ro + bj * HALF + n * 16) = rv + gv[bj][n] * acc[ai][bj][m][n]; } }
    }
};

typedef int v8i __attribute__((ext_vector_type(8)));
__device__ __forceinline__ unsigned pk4_fp8(float a, float b, float c, float d) { unsigned w = 0u; w = __builtin_amdgcn_cvt_pk_fp8_f32(a, b, w, false); w = __builtin_amdgcn_cvt_pk_fp8_f32(c, d, w, true); return w; }
struct EpiBf16F8 {
    static constexpr bool PERM = true, FP8 = true;
    float scale;
    __device__ __forceinline__ void operator()(const f32x4 (&acc)[2][2][4][2], const Unit& u, int wr, int wc, int fr, int fq) const { EpiBf16 E{scale}; E(acc, u, wr, wc, fr, fq); }
};
struct EpiPartF32 {
    static constexpr bool PERM = true, FP8 = true;
    float scale;
    __device__ __forceinline__ void operator()(const f32x4 (&acc)[2][2][4][2], const Unit& u, int wr, int wc, int fr, int fq) const {
        float* base = (float*)u.o + (size_t)(wr * 64 + fr) * 256 + wc * 32 + 8 * fq;
#pragma unroll
        for (int ai = 0; ai < 2; ++ai)
#pragma unroll
            for (int m = 0; m < 4; ++m) { float* rowp = base + (size_t)(ai * HALF + m * 16) * 256;
#pragma unroll
                for (int bj = 0; bj < 2; ++bj)
#pragma unroll
                    for (int n = 0; n < 2; ++n) *(f32x4*)(rowp + bj * HALF + 4 * n) = acc[ai][bj][m][n] * scale; }
    }
};
struct EpiSwiGLU8 {
    static constexpr bool PERM = true, FP8 = true;
    float sin, sout;
    __device__ __forceinline__ void operator()(const f32x4 (&acc)[2][2][4][2], const Unit& u, int wr, int wc, int fr, int fq) const {
        const size_t pitch = (size_t)u.ldc * 2;
        unsigned char* base = (unsigned char*)u.o + (size_t)(wr * 64 + fr) * pitch + wc * 32 + 8 * fq;
#pragma unroll
        for (int ai = 0; ai < 2; ++ai)
#pragma unroll
            for (int m = 0; m < 4; ++m) { unsigned char* rowp = base + (size_t)(ai * HALF + m * 16) * pitch;
                float r[8];
#pragma unroll
                for (int n = 0; n < 2; ++n)
#pragma unroll
                    for (int j = 0; j < 4; j += 2) {
                        const f32x2 A = (f32x2){acc[ai][0][m][n][j], acc[ai][0][m][n][j + 1]}, B = (f32x2){acc[ai][1][m][n][j], acc[ai][1][m][n][j + 1]};
                        const f32x2 t = A * (-1.4426950408889634f * sin); f32x2 d; d.x = __builtin_amdgcn_exp2f(t.x); d.y = __builtin_amdgcn_exp2f(t.y); d = d + 1.0f;
                        f32x2 q; q.x = __builtin_amdgcn_rcpf(d.x); q.y = __builtin_amdgcn_rcpf(d.y);
                        const f32x2 o = (A * B) * (sin * sin * sout) * q; r[n * 4 + j] = o.x; r[n * 4 + j + 1] = o.y; }
                u32x2 w; w.x = pk4_fp8(r[0], r[1], r[2], r[3]); w.y = pk4_fp8(r[4], r[5], r[6], r[7]);
                *(u32x2*)rowp = w; }
    }
};

template <class Epi, class Sched, bool ALIGN_EPI = true, bool SP2 = true>
__device__ __forceinline__ void gemm_phase(LAS unsigned char* lds, const Gemm g, const Sched& S, const Epi& E) {
    const int tid = threadIdx.x, wid = __builtin_amdgcn_readfirstlane(tid >> 6), lane = tid & 63, wr = wid >> 2, wc = wid & 3, fr = lane & 15, fq = lane >> 4;
    int K = g.K; asm volatile("" : "+s"(K));
    const int nt = K / BK;
    unsigned voffA[2], voffB[2];
#pragma unroll
    for (int i = 0; i < 2; ++i) { int R, C; stage_rc(tid * 16 + i * 8192, R, C); const int Rb = Epi::PERM ? ((R & ~31) + perm32(R & 31)) : R;
        voffA[i] = (unsigned)(R * g.lda + C) * 2u; voffB[i] = (unsigned)(Rb * g.ldb + C) * 2u; }
    const size_t kstep = (size_t)(BK * 2);
    const size_t hstepA = (size_t)HALF * g.lda * 2, hstepB = (size_t)HALF * g.ldb * 2;
    const unsigned ldsw = (unsigned)wid * 1024u;
    const int aoff = lds_byte(wr * 64 + fr, fq * 8), boff = lds_byte(wc * 32 + fr, fq * 8);
#define PG8_SA(b, h) (((b) * 2 + (h)) * HTB)
#define PG8_SB(b, h) ((4 + (b) * 2 + (h)) * HTB)
#define PG8_STAGE(bufoff, gbase, voff) do { _Pragma("unroll") for (int _i = 0; _i < 2; ++_i) \
        __builtin_amdgcn_global_load_lds((const unsigned*)((const char*)(gbase) + (voff)[_i]), (LAS unsigned*)(lds + (bufoff) + ldsw + _i * 8192), 16, 0, 0); } while (0)
#define PG8_LDA(dst, b, h) do { _Pragma("unroll") for (int m = 0; m < 4; ++m) _Pragma("unroll") for (int k = 0; k < 2; ++k) dst.f16[m][k] = *(const LAS bf16x8*)(lds + PG8_SA(b, h) + aoff + m * 2048 + k * 1024); } while (0)
#define PG8_LDB(dst, b, h) do { _Pragma("unroll") for (int n = 0; n < 2; ++n) _Pragma("unroll") for (int k = 0; k < 2; ++k) dst.f16[n][k] = *(const LAS bf16x8*)(lds + PG8_SB(b, h) + boff + n * 2048 + k * 1024); } while (0)
#define PG8_MMA(ai, bj, At, Bt) do { __builtin_amdgcn_s_setprio(1); _Pragma("unroll") for (int m = 0; m < 4; ++m) _Pragma("unroll") for (int n = 0; n < 2; ++n) { \
        if constexpr (Epi::FP8) asm volatile("v_mfma_f32_16x16x128_f8f6f4 %0, %1, %2, %0" : "+v"(acc[ai][bj][m][n]) : "v"(Bt.v[n]), "v"(At.v[m]));     \
        else { _Pragma("unroll") for (int k = 0; k < 2; ++k) acc[ai][bj][m][n] = __builtin_amdgcn_mfma_f32_16x16x32_bf16(Bt.f16[n][k], At.f16[m][k], acc[ai][bj][m][n], 0, 0, 0); } } \
        __builtin_amdgcn_s_setprio(0); } while (0)
#define PG8_MMAZ(ai, bj, At, Bt) do { __builtin_amdgcn_s_setprio(1); _Pragma("unroll") for (int m = 0; m < 4; ++m) _Pragma("unroll") for (int n = 0; n < 2; ++n) { \
        if constexpr (Epi::FP8) asm volatile("v_mfma_f32_16x16x128_f8f6f4 %0, %1, %2, 0" : "=&v"(acc[ai][bj][m][n]) : "v"(Bt.v[n]), "v"(At.v[m])); \
        else { acc[ai][bj][m][n] = __builtin_amdgcn_mfma_f32_16x16x32_bf16(Bt.f16[n][0], At.f16[m][0], (f32x4){0.f, 0.f, 0.f, 0.f}, 0, 0, 0); \
               acc[ai][bj][m][n] = __builtin_amdgcn_mfma_f32_16x16x32_bf16(Bt.f16[n][1], At.f16[m][1], acc[ai][bj][m][n], 0, 0, 0); } } \
        __builtin_amdgcn_s_setprio(0); } while (0)
#define PG8_WAIT_V(n) asm volatile("s_waitcnt vmcnt(" #n ")" ::: "memory")
#define PG8_WAIT_L(n) asm volatile("s_waitcnt lgkmcnt(" #n ")" ::: "memory")
#define PG8_BAR __builtin_amdgcn_s_barrier()
#define PG8_SCHED __builtin_amdgcn_sched_barrier(0)
    Unit cur, nxt; int ui = 0;
    if (!S.next(0, cur)) return;
    f32x4 acc[2][2][4][2];
    if constexpr (!(SP2 && Epi::FP8)) {
#pragma unroll
    for (int a = 0; a < 2; ++a)
#pragma unroll
        for (int b = 0; b < 2; ++b)
#pragma unroll
            for (int m = 0; m < 4; ++m)
#pragma unroll
                for (int n = 0; n < 2; ++n) acc[a][b][m][n] = (f32x4){0.f, 0.f, 0.f, 0.f};
    }
    union { bf16x8 f16[4][2]; v8i v[4]; } At;
    union { bf16x8 f16[2][2]; v8i v[2]; } B0, B1;
    const char* cA = cur.a; const char* cB = cur.b;
    if constexpr (SP2) {
        PG8_STAGE(PG8_SB(0, 0), cB, voffB); PG8_STAGE(PG8_SB(0, 1), cB + hstepB, voffB); PG8_STAGE(PG8_SA(0, 0), cA, voffA); PG8_STAGE(PG8_SA(0, 1), cA + hstepA, voffA);
        if (wr == 1) PG8_BAR;
        PG8_WAIT_V(2); PG8_BAR;
        PG8_STAGE(PG8_SB(1, 0), cB + kstep, voffB); PG8_STAGE(PG8_SA(1, 0), cA + kstep, voffA); PG8_STAGE(PG8_SB(1, 1), cB + hstepB + kstep, voffB);
        PG8_WAIT_V(6); PG8_BAR;
    } else {
        PG8_STAGE(PG8_SB(0, 0), cB, voffB); PG8_STAGE(PG8_SA(0, 0), cA, voffA); PG8_STAGE(PG8_SB(0, 1), cB + hstepB, voffB); PG8_STAGE(PG8_SA(0, 1), cA + hstepA, voffA);
        if (wr == 1) PG8_BAR;
        PG8_WAIT_V(4); PG8_BAR;
        PG8_STAGE(PG8_SB(1, 0), cB + kstep, voffB); PG8_STAGE(PG8_SA(1, 0), cA + kstep, voffA); PG8_STAGE(PG8_SB(1, 1), cB + hstepB + kstep, voffB);
        PG8_WAIT_V(6); PG8_BAR;
    }
    for (;;) {
        const bool has_next = S.next(ui + 1, nxt);
        const char* nA = has_next ? nxt.a : cA; const char* nB = has_next ? nxt.b : cB;
        for (int t = 0; t < nt; t += 2) {
            const bool last = (t == nt - 2);
            const char* a1 = cA + (size_t)(t + 1) * kstep;
            const char* a2 = last ? nA : cA + (size_t)(t + 2) * kstep; const char* b2 = last ? nB : cB + (size_t)(t + 2) * kstep;
            const char* a3 = a2 + kstep; const char* b3 = b2 + kstep;
            if constexpr (SP2) {
            PG8_LDB(B0, 0, 0); PG8_LDB(B1, 0, 1); PG8_SCHED; PG8_LDA(At, 0, 0); PG8_STAGE(PG8_SA(1, 1), a1 + hstepA, voffA);
            PG8_WAIT_V(8); PG8_WAIT_L(0); PG8_BAR; if (Epi::FP8 && t == 0) { PG8_MMAZ(0, 0, At, B0); PG8_MMAZ(0, 1, At, B1); } else { PG8_MMA(0, 0, At, B0); PG8_MMA(0, 1, At, B1); } PG8_BAR; PG8_SCHED;
            PG8_LDA(At, 0, 1); PG8_STAGE(PG8_SB(0, 0), b2, voffB); PG8_STAGE(PG8_SB(0, 1), b2 + hstepB, voffB); PG8_STAGE(PG8_SA(0, 0), a2, voffA);
            PG8_WAIT_V(8); PG8_WAIT_L(0); PG8_BAR; if (Epi::FP8 && t == 0) { PG8_MMAZ(1, 0, At, B0); PG8_MMAZ(1, 1, At, B1); } else { PG8_MMA(1, 0, At, B0); PG8_MMA(1, 1, At, B1); } PG8_BAR; PG8_SCHED;
            PG8_LDB(B0, 1, 0); PG8_LDB(B1, 1, 1); PG8_SCHED; PG8_LDA(At, 1, 0); PG8_STAGE(PG8_SA(0, 1), a2 + hstepA, voffA);
            PG8_WAIT_V(8); PG8_WAIT_L(0); PG8_BAR; PG8_MMA(0, 0, At, B0); PG8_MMA(0, 1, At, B1); PG8_BAR; PG8_SCHED;
            PG8_LDA(At, 1, 1); PG8_STAGE(PG8_SB(1, 0), b3, voffB); PG8_STAGE(PG8_SB(1, 1), b3 + hstepB, voffB); PG8_STAGE(PG8_SA(1, 0), a3, voffA);
            PG8_WAIT_V(8); PG8_WAIT_L(0); PG8_BAR; PG8_MMA(1, 0, At, B0); PG8_MMA(1, 1, At, B1); PG8_BAR; PG8_SCHED;
            } else {
            PG8_LDB(B0, 0, 0); PG8_SCHED; PG8_LDA(At, 0, 0); PG8_STAGE(PG8_SA(1, 1), a1 + hstepA, voffA);
            PG8_WAIT_L(8); PG8_BAR; PG8_WAIT_L(0); PG8_MMA(0, 0, At, B0); PG8_BAR; PG8_SCHED;
            PG8_LDB(B1, 0, 1); PG8_STAGE(PG8_SB(0, 0), b2, voffB);
            PG8_BAR; PG8_WAIT_L(0); PG8_MMA(0, 1, At, B1); PG8_BAR;
            PG8_LDA(At, 0, 1); PG8_STAGE(PG8_SA(0, 0), a2, voffA);
            PG8_BAR; PG8_WAIT_L(0); PG8_MMA(1, 0, At, B0); PG8_BAR; PG8_SCHED;
            PG8_STAGE(PG8_SB(0, 1), b2 + hstepB, voffB);
            PG8_WAIT_V(6); PG8_BAR; PG8_MMA(1, 1, At, B1); PG8_BAR;
            PG8_LDB(B0, 1, 0); PG8_SCHED; PG8_LDA(At, 1, 0); PG8_STAGE(PG8_SA(0, 1), a2 + hstepA, voffA);
            PG8_WAIT_L(8); PG8_BAR; PG8_WAIT_L(0); PG8_MMA(0, 0, At, B0); PG8_BAR; PG8_SCHED;
            PG8_LDB(B1, 1, 1); PG8_STAGE(PG8_SB(1, 0), b3, voffB);
            PG8_BAR; PG8_WAIT_L(0); PG8_MMA(0, 1, At, B1); PG8_BAR;
            PG8_LDA(At, 1, 1); PG8_STAGE(PG8_SA(1, 0), a3, voffA);
            PG8_BAR; PG8_WAIT_L(0); PG8_MMA(1, 0, At, B0); PG8_BAR; PG8_SCHED;
            PG8_STAGE(PG8_SB(1, 1), b3 + hstepB, voffB);
            PG8_WAIT_V(6); PG8_BAR; PG8_MMA(1, 1, At, B1); PG8_BAR;
            }
        }
        if constexpr (ALIGN_EPI) { if (wr == 0) PG8_BAR; }
        if constexpr (Epi::FP8) asm volatile("s_nop 15\n\ts_nop 15" ::: "memory");
        E(acc, cur, wr, wc, fr, fq);
        if (!has_next) break;
        if constexpr (!(SP2 && Epi::FP8)) {
#pragma unroll
        for (int a = 0; a < 2; ++a)
#pragma unroll
            for (int b = 0; b < 2; ++b)
#pragma unroll
                for (int m = 0; m < 4; ++m)
#pragma unroll
                    for (int n = 0; n < 2; ++n) acc[a][b][m][n] = (f32x4){0.f, 0.f, 0.f, 0.f};
        }
        cur = nxt; cA = nA; cB = nB; ++ui;
        if constexpr (ALIGN_EPI) { if (wr == 1) PG8_BAR; }
    }
    PG8_WAIT_V(0);
    if constexpr (!ALIGN_EPI) { if (wr == 0) PG8_BAR; }
    PG8_BAR;
#undef PG8_SA
#undef PG8_SB
#undef PG8_STAGE
#undef PG8_LDA
#undef PG8_LDB
#undef PG8_MMA
#undef PG8_MMAZ
#undef PG8_WAIT_V
#undef PG8_WAIT_L
#undef PG8_BAR
#undef PG8_SCHED
}
}

constexpr int NWAVES = 8, NTHR = 512;
constexpr int D = 1024, NB = 4, SEQ = 4096, NT = NB * SEQ, CTX = 256, NCTX = NB * CTX;
constexpr int CH = 512;
constexpr int NH = 16, DH = 32;
constexpr int NZ = 3072, DFF = 2816, NE = 8, DFE = 3584, NMOD = 6 * D;
constexpr int CAPROWS = 2 * NT + NE * 256;
constexpr float EPS = 1e-6f;

constexpr size_t MiB = 1u << 20;
constexpr size_t WS_CTL = 0, CTL_ZERO_BYTES = 1 * MiB;
constexpr size_t WS_MOD = 1 * MiB;
constexpr size_t WS_ROUTE = 1 * MiB + 512 * 1024;
constexpr size_t WS_SHW = 1 * MiB + 256 * 1024;
constexpr size_t WS_DSH = 1 * MiB + 384 * 1024;
constexpr size_t WS_RB = 59 * MiB;
constexpr size_t WS_DFTCH = 2 * MiB;
constexpr size_t WS_MOEUP = 3 * MiB;
constexpr size_t WS_MOEDN = 115 * MiB;
constexpr size_t WS_ACOMP = 171 * MiB;
constexpr size_t WS_MACT = 239 * MiB;
constexpr size_t WS_ACS = 358 * MiB;
constexpr size_t WS_END = 486 * MiB;
constexpr size_t WS_WIN = 171 * MiB, WS_WMIX = 177 * MiB, WS_WUP = 179 * MiB, WS_WDN = 190 * MiB, WS_WFOU = 196 * MiB;
constexpr size_t WS_KT = 198 * MiB;
constexpr size_t WS_Y = 198 * MiB;
constexpr size_t WS_H = 230 * MiB, WS_HC = 262 * MiB;
constexpr size_t WS_QK = 264 * MiB, WS_VT = 296 * MiB, WS_HYT = 312 * MiB, WS_KC = 360 * MiB, WS_VCT = 361 * MiB, WS_YCAT = 362 * MiB;
constexpr size_t WS_ACT = 264 * MiB;
constexpr size_t WS_DFTSEQ = 264 * MiB, WS_PQT = 328 * MiB;
constexpr size_t WS_H2 = 400 * MiB;
constexpr size_t WS_YT = 432 * MiB;
static_assert(WS_MACT + (size_t)CAPROWS * DFE <= WS_ACS && WS_ACOMP + (size_t)CAPROWS * D * 2 <= WS_MACT && WS_ACS + (size_t)NE * NT * D <= WS_END, "ws map");
constexpr int CW_BAR = 4096;
constexpr int CW_CNT = 16384;
constexpr int CW_FLAG = 8192;
constexpr int CW_SS = 65536;

constexpr int RING_BYTES = 131072;
constexpr int LDS_BYTES = 163840;
constexpr int MISC_OFF = LDS_BYTES - 256;

#define LDS_WAIT() asm volatile("s_waitcnt lgkmcnt(0)" ::: "memory")
#define VM_WAIT() asm volatile("s_waitcnt vmcnt(0)" ::: "memory")
__device__ __forceinline__ unsigned pk2(float lo, float hi) { return pg8::cvt_pk_bf16(lo, hi); }
__device__ __forceinline__ float bf2f(unsigned short v) { return __uint_as_float((unsigned)v << 16); }
__device__ __forceinline__ float wave_sum(float v) {
#pragma unroll
    for (int o = 1; o < 64; o <<= 1) v += __shfl_xor(v, o);
    return v;
}

struct Frame {
    LAS unsigned char* lds;
    int tid, lane, wave, G, bid;
    const float* const* in;
    float* out;
    unsigned char* ws;
};

typedef unsigned long long u64;
constexpr float SS_SCALE = 1048576.0f;
__device__ __forceinline__ float ld_ss(const u64* p) { return (float)__hip_atomic_load(p, __ATOMIC_RELAXED, __HIP_MEMORY_SCOPE_AGENT) * (1.0f / SS_SCALE); }
__device__ __forceinline__ u32x4 pk8(const f32x4 a, const f32x4 b) { u32x4 w; w.x = pk2(a.x, a.y); w.y = pk2(a.z, a.w); w.z = pk2(b.x, b.y); w.w = pk2(b.z, b.w); return w; }
template <bool RF32, bool NORM>
struct EpiResN {
    static constexpr bool PERM = true, FP8 = false;
    const float* Rf; const bf16* Rb; bf16* XB; bf16* H; const float* gate; const float* g; const float* sc; u64* SS;
    __device__ __forceinline__ void operator()(const f32x4 (&acc)[2][2][4][2], const pg8::Unit& u, int wr, int wc, int fr, int fq) const {
        const int b = u.row0 >> 12, row0 = u.row0 + wr * 64 + fr, colb = u.col0 + wc * 32 + 8 * fq;
        f32x4 gv[2][2], gsv[2][2];
#pragma unroll
        for (int bj = 0; bj < 2; ++bj)
#pragma unroll
            for (int n = 0; n < 2; ++n) { const int c = colb + bj * pg8::HALF + 4 * n; gv[bj][n] = *(const f32x4*)(gate + (size_t)b * NMOD + c);
                if constexpr (NORM) gsv[bj][n] = *(const f32x4*)(g + c) * (*(const f32x4*)(sc + (size_t)b * NMOD + c) + 1.0f); }
#pragma unroll
        for (int ai = 0; ai < 2; ++ai)
#pragma unroll
            for (int m = 0; m < 4; ++m) { const int row = row0 + ai * pg8::HALF + m * 16; const size_t ro = (size_t)row * 1024 + colb; float ss = 0.f;
#pragma unroll
                for (int bj = 0; bj < 2; ++bj) { f32x4 r0, r1;
                    if constexpr (RF32) { r0 = *(const f32x4*)(Rf + ro + bj * pg8::HALF); r1 = *(const f32x4*)(Rf + ro + bj * pg8::HALF + 4); }
                    else { const u32x4 q = *(const u32x4*)(Rb + ro + bj * pg8::HALF);
                        r0 = (f32x4){__uint_as_float(q.x << 16), __uint_as_float(q.x & 0xffff0000u), __uint_as_float(q.y << 16), __uint_as_float(q.y & 0xffff0000u)};
                        r1 = (f32x4){__uint_as_float(q.z << 16), __uint_as_float(q.z & 0xffff0000u), __uint_as_float(q.w << 16), __uint_as_float(q.w & 0xffff0000u)}; }
                    const f32x4 x0 = r0 + gv[bj][0] * acc[ai][bj][m][0], x1 = r1 + gv[bj][1] * acc[ai][bj][m][1];
                    *(u32x4*)(XB + ro + bj * pg8::HALF) = pk8(x0, x1);
                    if constexpr (NORM) { *(u32x4*)(H + ro + bj * pg8::HALF) = pk8(x0 * gsv[bj][0], x1 * gsv[bj][1]);
                        ss += ((x0.x * x0.x + x0.y * x0.y) + (x0.z * x0.z + x0.w * x0.w)) + ((x1.x * x1.x + x1.y * x1.y) + (x1.z * x1.z + x1.w * x1.w)); } }
                if constexpr (NORM) { ss += __shfl_xor(ss, 16); ss += __shfl_xor(ss, 32);
                    if (fq == 0) (void)__hip_atomic_fetch_add(SS + row, (u64)(ss * SS_SCALE), __ATOMIC_RELAXED, __HIP_MEMORY_SCOPE_AGENT); } }
    }
};
struct EpiSwiGLUN {
    static constexpr bool PERM = true, FP8 = false;
    const LAS float* rsl; const float* shW;
    __device__ __forceinline__ void operator()(const f32x4 (&acc)[2][2][4][2], const pg8::Unit& u, int wr, int wc, int fr, int fq) const {
        bf16* base = (bf16*)u.o + (size_t)(wr * 64 + fr) * u.ldc + wc * 32 + 8 * fq;
        const float* sp = shW + (size_t)(u.row0 >> 12) * (2 * DFF) + u.col0 + wc * 32 + 8 * fq;
        float rs[2][4];
#pragma unroll
        for (int ai = 0; ai < 2; ++ai)
#pragma unroll
            for (int m = 0; m < 4; ++m) rs[ai][m] = rsl[u.aux * 256 + ai * pg8::HALF + wr * 64 + m * 16 + fr];
        f32x4 s1[2], s3[2];
#pragma unroll
        for (int n = 0; n < 2; ++n) { s1[n] = *(const f32x4*)(sp + 4 * n); s3[n] = *(const f32x4*)(sp + pg8::HALF + 4 * n); }
#pragma unroll
        for (int ai = 0; ai < 2; ++ai)
#pragma unroll
            for (int m = 0; m < 4; ++m) { bf16* rowp = base + (size_t)(ai * pg8::HALF + m * 16) * u.ldc;
                const float rstd = rs[ai][m];
                float r[8];
#pragma unroll
                for (int n = 0; n < 2; ++n)
#pragma unroll
                    for (int j = 0; j < 4; j += 2) {
                        const f32x2 A = (f32x2){acc[ai][0][m][n][j], acc[ai][0][m][n][j + 1]} * rstd + (f32x2){s1[n][j], s1[n][j + 1]}, B = (f32x2){acc[ai][1][m][n][j], acc[ai][1][m][n][j + 1]} * rstd + (f32x2){s3[n][j], s3[n][j + 1]};
                        const f32x2 t = A * (-1.4426950408889634f); f32x2 d; d.x = __builtin_amdgcn_exp2f(t.x); d.y = __builtin_amdgcn_exp2f(t.y); d = d + 1.0f;
                        f32x2 q; q.x = __builtin_amdgcn_rcpf(d.x); q.y = __builtin_amdgcn_rcpf(d.y);
                        const f32x2 o = (A * B) * q; r[n * 4 + j] = o.x; r[n * 4 + j + 1] = o.y; }
                u32x4 w; w.x = pk2(r[0], r[1]); w.y = pk2(r[2], r[3]); w.z = pk2(r[4], r[5]); w.w = pk2(r[6], r[7]);
                *(u32x4*)rowp = w; }
    }
};
struct EpiDftN {
    static constexpr bool PERM = true, FP8 = false;
    const LAS float* rsl; const float* dsh;
    __device__ __forceinline__ void operator()(const f32x4 (&acc)[2][2][4][2], const pg8::Unit& u, int wr, int wc, int fr, int fq) const {
        bf16* base = (bf16*)u.o + (size_t)(wr * 64 + fr) * u.ldc + wc * 32 + 8 * fq;
        f32x4 rs[2][2];
#pragma unroll
        for (int bj = 0; bj < 2; ++bj)
#pragma unroll
            for (int n = 0; n < 2; ++n) rs[bj][n] = *(const LAS f32x4*)(rsl + u.aux * 256 + bj * pg8::HALF + wc * 32 + 8 * fq + 4 * n);
#pragma unroll
        for (int ai = 0; ai < 2; ++ai)
#pragma unroll
            for (int m = 0; m < 4; ++m) { bf16* rowp = base + (size_t)(ai * pg8::HALF + m * 16) * u.ldc;
                const float sh = dsh[u.row0 * 256 + ai * pg8::HALF + wr * 64 + m * 16 + fr];
#pragma unroll
                for (int bj = 0; bj < 2; ++bj) *(u32x4*)(rowp + bj * pg8::HALF) = pk8(acc[ai][bj][m][0] * rs[bj][0] + sh, acc[ai][bj][m][1] * rs[bj][1] + sh); }
    }
};

constexpr int CV_NW = 64, CV_SCR = 128 * 33 * 4;
constexpr int I_IN = 16 * (NZ / CV_NW), I_SQ = 16 * (D / CV_NW), I_UP = 16 * (DFF / CV_NW), I_DN = (DFF / 64) * (D / CV_NW), CV_PLAIN = I_IN + 2 * I_SQ + 2 * I_UP + I_DN;
constexpr int I_MU = (D / 128) * (DFE / 32), I_MD = (DFE / 128) * (D / 32);
constexpr int MOE_ITEMS = NE * (2 * I_MU + I_MD), CV_ITEMS = CV_PLAIN + MOE_ITEMS;
constexpr int MOE_DEFER_P2 = 5000, MOE_DEFER_P6 = 4500;
struct CvJob { const float* src; bf16* dst; int N, ldt, f8; };
constexpr float W8_SCALE = 64.0f, H8_SCALE = 16.0f, A8_SCALE = 8.0f;
__device__ __forceinline__ void cv_plain(CvJob& j, const float* W, int K, int N, bf16* WT, int item) { const int nblk = N / CV_NW, kb = item / nblk, nb = item % nblk; j.src = W + (size_t)(64 * kb) * N + CV_NW * nb; j.dst = WT + (size_t)(CV_NW * nb) * K + 64 * kb; j.N = N; j.ldt = K; j.f8 = 0; }
__device__ __forceinline__ void cv_up(CvJob& j, const float* W, int K, int N, bf16* WT, int which, int item) { const int nblk = N / CV_NW, kb = item / nblk, nb = item % nblk, n0 = CV_NW * nb;
    j.src = W + (size_t)(64 * kb) * N + n0; j.dst = WT + (size_t)((n0 >> 7) * 256 + which * 128 + (n0 & 127)) * K + 64 * kb; j.N = N; j.ldt = K; j.f8 = 0; }
__device__ __forceinline__ void cv8_plain(CvJob& j, const float* W, int K, int N, unsigned char* WT, int item) { const int nblk = N / 32, kb = item / nblk, nb = item % nblk; j.src = W + (size_t)(128 * kb) * N + 32 * nb; j.dst = (bf16*)(WT + (size_t)(32 * nb) * K + 128 * kb); j.N = N; j.ldt = K; j.f8 = 1; }
__device__ __forceinline__ void cv8_up(CvJob& j, const float* W, int K, int N, unsigned char* WT, int which, int item) { const int nblk = N / 32, kb = item / nblk, nb = item % nblk, n0 = 32 * nb;
    j.src = W + (size_t)(128 * kb) * N + n0; j.dst = (bf16*)(WT + (size_t)((n0 >> 7) * 256 + which * 128 + (n0 & 127)) * K + 128 * kb); j.N = N; j.ldt = K; j.f8 = 1; }
__device__ __forceinline__ void cv_job(Frame& F, int it, CvJob& j) {
    int r = it;
    if (r < I_IN) { cv_plain(j, F.in[7], D, NZ, (bf16*)(F.ws + WS_WIN), r); return; } r -= I_IN;
    if (r < I_SQ) { cv_plain(j, F.in[18], D, D, (bf16*)(F.ws + WS_WMIX), r); return; } r -= I_SQ;
    if (r < I_SQ) { cv_plain(j, F.in[22], D, D, (bf16*)(F.ws + WS_WFOU), r); const int nblk = D / CV_NW, kb = r / nblk, nb = r % nblk; j.src = F.in[22] + CV_NW * nb; j.f8 = 2 | (kb << 8); return; } r -= I_SQ;
    if (r < I_UP) { cv_up(j, F.in[19], D, DFF, (bf16*)(F.ws + WS_WUP), 0, r); return; } r -= I_UP;
    if (r < I_UP) { cv_up(j, F.in[20], D, DFF, (bf16*)(F.ws + WS_WUP), 1, r); return; } r -= I_UP;
    if (r < I_DN) { cv_plain(j, F.in[21], DFF, D, (bf16*)(F.ws + WS_WDN), r); return; } r -= I_DN;
    if (r < NE * I_MU) { const int e = r / I_MU; cv8_up(j, F.in[25] + (size_t)e * D * DFE, D, DFE, F.ws + WS_MOEUP + (size_t)e * 2 * DFE * D, 0, r % I_MU); return; } r -= NE * I_MU;
    if (r < NE * I_MU) { const int e = r / I_MU; cv8_up(j, F.in[26] + (size_t)e * D * DFE, D, DFE, F.ws + WS_MOEUP + (size_t)e * 2 * DFE * D, 1, r % I_MU); return; } r -= NE * I_MU;
    { const int e = r / I_MD; cv8_plain(j, F.in[27] + (size_t)e * DFE * D, DFE, D, F.ws + WS_MOEDN + (size_t)e * D * DFE, r % I_MD); }
}
__device__ __forceinline__ int fy_src_row(int kp) { const int g = kp >> 8, s = kp & 255, m = s >> 4, jj = s & 15; const int c = (s == 255) ? 0 : (jj < 8 ? 8 * m + 1 + jj : 255 - 8 * m - (jj - 8)); return g * 256 + c; }
__device__ __forceinline__ void cv_load(const CvJob& j, int lane, f32x4 (&v)[16]) {
    const int f8 = j.f8 & 1, rs = f8 ? 8 : 4, lr = f8 ? (lane >> 3) : (lane >> 4), lc = f8 ? 4 * (lane & 7) : 4 * (lane & 15);
    if (j.f8 & 2) {
        const int k0 = (j.f8 >> 8) * 64;
#pragma unroll
        for (int i = 0; i < 16; ++i) v[i] = __builtin_nontemporal_load((const f32x4*)(j.src + (size_t)fy_src_row(k0 + 4 * i + lr) * j.N + lc));
        return; }
    const float* src = j.src + (size_t)lr * j.N + lc;
#pragma unroll
    for (int i = 0; i < 16; ++i) v[i] = __builtin_nontemporal_load((const f32x4*)(src + (size_t)(rs * i) * j.N));
}
__device__ __forceinline__ void cv_store(const CvJob& j, int lane, const f32x4 (&v)[16], LAS float* scr) {
    if (j.f8 & 1) {
        const int lr = lane >> 3, lc = 4 * (lane & 7);
#pragma unroll
        for (int i = 0; i < 16; ++i) { LAS float* d = scr + (8 * i + lr) * 33 + lc; d[0] = v[i].x; d[1] = v[i].y; d[2] = v[i].z; d[3] = v[i].w; }
        LDS_WAIT(); asm volatile("" ::: "memory");
        const int c = lane & 7;
#pragma unroll
        for (int q = 0; q < 4; ++q) { const int n = (lane >> 3) + 8 * q; const LAS float* s = scr + (16 * c) * 33 + n;
            u32x4 o;
            o.x = pg8::pk4_fp8(s[0 * 33] * W8_SCALE, s[1 * 33] * W8_SCALE, s[2 * 33] * W8_SCALE, s[3 * 33] * W8_SCALE); o.y = pg8::pk4_fp8(s[4 * 33] * W8_SCALE, s[5 * 33] * W8_SCALE, s[6 * 33] * W8_SCALE, s[7 * 33] * W8_SCALE);
            o.z = pg8::pk4_fp8(s[8 * 33] * W8_SCALE, s[9 * 33] * W8_SCALE, s[10 * 33] * W8_SCALE, s[11 * 33] * W8_SCALE); o.w = pg8::pk4_fp8(s[12 * 33] * W8_SCALE, s[13 * 33] * W8_SCALE, s[14 * 33] * W8_SCALE, s[15 * 33] * W8_SCALE);
            *(u32x4*)((unsigned char*)j.dst + (size_t)n * j.ldt + 16 * c) = o; }
    } else {
        const int lr = lane >> 4, lc = 4 * (lane & 15);
#pragma unroll
        for (int i = 0; i < 16; ++i) { LAS float* d = scr + (4 * i + lr) * 65 + lc; d[0] = v[i].x; d[1] = v[i].y; d[2] = v[i].z; d[3] = v[i].w; }
        LDS_WAIT(); asm volatile("" ::: "memory");
        const int c = lane & 7;
#pragma unroll
        for (int q = 0; q < 8; ++q) { const int n = (lane >> 3) + 8 * q; const LAS float* s = scr + (8 * c) * 65 + n;
            u32x4 o; o.x = pk2(s[0 * 65], s[1 * 65]); o.y = pk2(s[2 * 65], s[3 * 65]); o.z = pk2(s[4 * 65], s[5 * 65]); o.w = pk2(s[6 * 65], s[7 * 65]);
            *(u32x4*)(j.dst + (size_t)n * j.ldt + 8 * c) = o; }
    }
    LDS_WAIT(); asm volatile("" ::: "memory");
}
__device__ __forceinline__ void convert_items(Frame& F, int lo, int hi, int w, int nw, LAS float* scr) {
    int it = lo + w; if (it >= hi) return;
    CvJob ja, jb; f32x4 va[16], vb[16];
    cv_job(F, it, ja); cv_load(ja, F.lane, va);
    for (;;) {
        const int itb = it + nw; const bool hb = itb < hi;
        if (hb) { cv_job(F, itb, jb); cv_load(jb, F.lane, vb); }
        cv_store(ja, F.lane, va, scr);
        if (!hb) break;
        const int ita = itb + nw; const bool ha = ita < hi;
        if (ha) { cv_job(F, ita, ja); cv_load(ja, F.lane, va); }
        cv_store(jb, F.lane, vb, scr);
        if (!ha) break;
        it = ita;
    }
}
__device__ __forceinline__ void moe_tail_convert(Frame& F, int nunits, int lo, int hi) {
    const int rem = nunits % F.G;
    if (rem == 0 || F.bid < rem) return;
    convert_items(F, lo, hi, (F.bid - rem) * NWAVES + F.wave, (F.G - rem) * NWAVES, (LAS float*)(F.lds + F.wave * CV_SCR));
}

__device__ __forceinline__ void p0_prologue(Frame& F) {
    const int tid = F.tid;
    LAS float* sil = (LAS float*)(F.lds);
    LAS float* red = (LAS float*)(F.lds + 20480);
    LAS float* feats = (LAS float*)(F.lds + 61440);
    LAS float* hid1 = (LAS float*)(F.lds + 65536);
    LAS float* hid2 = (LAS float*)(F.lds + 69632);
    const float* cvec = F.in[1]; const float* cctx = F.in[3];
    { float cv[10];
#pragma unroll
      for (int q = 0; q < 8; ++q) cv[q] = cvec[tid + NTHR * q];
      cv[8] = cctx[tid]; cv[9] = cctx[tid + NTHR];
#pragma unroll
      for (int q = 0; q < 10; ++q) sil[tid + NTHR * q] = cv[q] / (1.0f + __expf(-cv[q])); }
    __syncthreads();
    float* MOD = (float*)(F.ws + WS_MOD);
    float* KT = (float*)(F.ws + WS_KT);
    for (int it = F.bid; it < 192 + 256; it += F.G) {
        if (it < 192) {
            const int l = it / 96, s = it % 96, cq = tid & 15, kg = tid >> 4;
            const float* W = F.in[4] + (size_t)l * D * NMOD + 64 * s + 4 * cq;
            f32x4 a[5];
#pragma unroll
            for (int r = 0; r < 5; ++r) a[r] = (f32x4){0.f, 0.f, 0.f, 0.f};
#pragma unroll 1
            for (int k0 = kg * 32; k0 < kg * 32 + 32; k0 += 16) { f32x4 w[16];
#pragma unroll
                for (int kk = 0; kk < 16; ++kk) w[kk] = *(const f32x4*)(W + (size_t)(k0 + kk) * NMOD);
#pragma unroll
                for (int kk = 0; kk < 16; ++kk)
#pragma unroll
                    for (int r = 0; r < 5; ++r) a[r] += sil[r * 1024 + k0 + kk] * w[kk]; }
#pragma unroll
            for (int r = 0; r < 5; ++r) *(LAS f32x4*)(red + (kg * 5 + r) * 64 + 4 * cq) = a[r];
            __syncthreads();
            if (tid < 320) { const int r = tid >> 6, cc = tid & 63; float sum = F.in[5][l * NMOD + 64 * s + cc];
#pragma unroll 8
                for (int q = 0; q < 32; ++q) sum += red[(q * 5 + r) * 64 + cc];
                __hip_atomic_store((unsigned*)(MOD + (size_t)(l * 5 + r) * NMOD + 64 * s + cc), __float_as_uint(sum), __ATOMIC_RELAXED, __HIP_MEMORY_SCOPE_AGENT); }
            __syncthreads();
            if (l == 0 && s < 32 && tid == 0) (void)xb_add((unsigned*)(F.ws + WS_CTL) + CW_FLAG, 1u);
        } else {
            const int fi = it - 192, t0 = 16 * ((fi & ~9) | ((fi & 1) << 3) | ((fi >> 3) & 1));
            for (int idx = tid; idx < 16 * 33; idx += NTHR) { const int r = idx / 33, f = idx % 33; const float n = (float)(t0 + r); float v;
                if (f == 0) v = n * (1.0f / 4095.0f);
                else { const int j = (f - 1) & 15; const float band = 1e-4f + (float)j * ((15.0f - 1e-4f) / 15.0f); const float ang = (6.283185307179586f / 4096.0f) * n * band; v = (f <= 16) ? cosf(ang) : -sinf(ang); }
                feats[idx] = v; }
            __syncthreads();
            { const int r = tid >> 6; int j = tid & 63; asm volatile("" : "+v"(j));
              const float* W1 = F.in[10] + j; const float b1 = F.in[11][j], f1 = F.in[15][j];
              float w[33];
#pragma unroll
              for (int f = 0; f < 33; ++f) w[f] = W1[f * 64];
              float s0 = b1, s1 = b1;
#pragma unroll
              for (int f = 0; f < 33; ++f) { s0 += feats[r * 33 + f] * w[f]; s1 += feats[(r + 8) * 33 + f] * w[f]; }
              hid1[tid] = sinf(f1 * s0); hid1[tid + NTHR] = sinf(f1 * s1); }
            __syncthreads();
            { const int r = tid >> 6; int j = tid & 63; asm volatile("" : "+v"(j));
              const float* W2 = F.in[12] + j; const float b2 = F.in[13][j], f2 = F.in[15][64 + j];
              float s0 = b2, s1 = b2;
#pragma unroll
              for (int i0 = 0; i0 < 64; i0 += 32) { float w[32];
#pragma unroll
                  for (int i = 0; i < 32; ++i) w[i] = W2[(i0 + i) * 64];
#pragma unroll
                  for (int i = 0; i < 32; ++i) { s0 += hid1[r * 64 + i0 + i] * w[i]; s1 += hid1[(r + 8) * 64 + i0 + i] * w[i]; } }
              hid2[tid] = sinf(f2 * s0); hid2[tid + NTHR] = sinf(f2 * s1); }
            __syncthreads();
            { const int col4 = tid * 4; f32x4 acc[16];
#pragma unroll
              for (int r = 0; r < 16; ++r) acc[r] = (f32x4){0.f, 0.f, 0.f, 0.f};
              const float* W3 = F.in[14] + col4;
#pragma unroll 1
              for (int j0 = 0; j0 < 64; j0 += 16) { f32x4 w[16];
#pragma unroll
                  for (int jj = 0; jj < 16; ++jj) w[jj] = *(const f32x4*)(W3 + (j0 + jj) * 2048);
#pragma unroll
                  for (int jj = 0; jj < 16; ++jj)
#pragma unroll
                      for (int r = 0; r < 16; ++r) acc[r] += hid2[r * 64 + j0 + jj] * w[jj]; }
#pragma unroll
              for (int e = 0; e < 4; ++e) { const int col = col4 + e, c = col & 511, od = col >> 9;
                  const float delta = 3.0701134573253944f + (float)c * ((15.350567286626972f - 3.0701134573253944f) / 511.0f);
                  float* dst = KT + ((size_t)od * 512 + c) * 4096 + t0;
#pragma unroll
                  for (int r4 = 0; r4 < 4; ++r4) { f32x4 o;
#pragma unroll
                      for (int q = 0; q < 4; ++q) { const int r = r4 * 4 + q; const float t = (float)(t0 + r) * (1.0f / 4095.0f); o[q] = acc[r][e] * __expf(-t * delta); }
                      *(f32x4*)(dst + r4 * 4) = o; } } }
            __syncthreads();
        }
    }
    __syncthreads();
    convert_items(F, 0, CV_ITEMS - MOE_DEFER_P2 - MOE_DEFER_P6, F.bid * NWAVES + F.wave, F.G * NWAVES, (LAS float*)(F.lds + F.wave * CV_SCR));
    bf16* DC = (bf16*)(F.ws + WS_DFTCH);
    for (int idx = F.bid * NTHR + tid; idx < 256 * 256; idx += F.G * NTHR) { const int row = idx >> 8, j = idx & 255, cs = row >= 129, k = cs ? row - 128 : row, m = (j * k) & 255;
        const float ang = (float)m * (6.283185307179586f / 256.0f); const float v = (cs ? sinf(ang) : cosf(ang)) * (1.0f / 16.0f);
        DC[idx] = (bf16)(pk2(v, 0.f) & 0xffffu); }
}

__device__ __forceinline__ void norm_phase(Frame& F, const float* src_main, int n_main, bf16* dst_main, const float* src_ctx, int n_ctx, bf16* dst_ctx, const float* g, const float* mod, int ish, int isc) {
    LAS float* gs = (LAS float*)(F.lds);
    LAS float* sv = (LAS float*)(F.lds + 20480);
    { float tg[10], ts[10], th[10];
#pragma unroll
      for (int q = 0; q < 10; ++q) { const int i = F.tid + NTHR * q, b = i >> 10, k = i & 1023; tg[q] = g[k]; ts[q] = mod[(size_t)b * NMOD + isc * D + k]; th[q] = mod[(size_t)b * NMOD + ish * D + k]; }
#pragma unroll
      for (int q = 0; q < 10; ++q) { const int i = F.tid + NTHR * q; gs[i] = tg[q] * (1.0f + ts[q]); sv[i] = th[q]; } }
    __syncthreads();
    const int gw = F.bid * NWAVES + F.wave, NGW = F.G * NWAVES, NR = n_main + n_ctx;
#pragma unroll 1
    for (int row = gw; row < NR; row += 2 * NGW) {
        const int row1 = row + NGW; const bool h1 = row1 < NR; const int r1 = h1 ? row1 : row;
        f32x4 v[2][4];
#pragma unroll
        for (int u = 0; u < 2; ++u) { const int rr = u ? r1 : row; const float* xr = ((rr >= n_main) ? src_ctx + (size_t)(rr - n_main) * D : src_main + (size_t)rr * D) + 8 * F.lane;
#pragma unroll
            for (int hh = 0; hh < 2; ++hh) { v[u][2 * hh] = *(const f32x4*)(xr + 512 * hh); v[u][2 * hh + 1] = *(const f32x4*)(xr + 512 * hh + 4); } }
#pragma unroll
        for (int u = 0; u < 2; ++u) { const int rr = u ? r1 : row; if (u == 1 && !h1) break;
            const bool isctx = rr >= n_main; const int b = isctx ? 4 : (rr >> 12);
            bf16* orow = isctx ? dst_ctx + (size_t)(rr - n_main) * D : dst_main + (size_t)rr * D;
            float s = 0.f;
#pragma unroll
            for (int j = 0; j < 4; ++j) s += (v[u][j].x * v[u][j].x + v[u][j].y * v[u][j].y) + (v[u][j].z * v[u][j].z + v[u][j].w * v[u][j].w);
            const float rstd = 1.0f / sqrtf(wave_sum(s) * (1.0f / D) + EPS);
#pragma unroll
            for (int hh = 0; hh < 2; ++hh) { const int k = 8 * F.lane + 512 * hh;
                const f32x4 a0 = *(const LAS f32x4*)(gs + b * 1024 + k), a1 = *(const LAS f32x4*)(gs + b * 1024 + k + 4), c0 = *(const LAS f32x4*)(sv + b * 1024 + k), c1 = *(const LAS f32x4*)(sv + b * 1024 + k + 4);
                const f32x4 o0 = v[u][2 * hh] * rstd * a0 + c0, o1 = v[u][2 * hh + 1] * rstd * a1 + c1;
                u32x4 w; w.x = pk2(o0.x, o0.y); w.y = pk2(o0.z, o0.w); w.z = pk2(o1.x, o1.y); w.w = pk2(o1.z, o1.w); *(u32x4*)(orow + k) = w; } }
    }
    __syncthreads();
}

__device__ __forceinline__ void shift_gemvs(Frame& F, const float* mod0, const float* mod1, int gw, int NGW) {
    const bf16* WUP = (const bf16*)(F.ws + WS_WUP); const bf16* DC = (const bf16*)(F.ws + WS_DFTCH);
    float* SHW = (float*)(F.ws + WS_SHW); float* DSH = (float*)(F.ws + WS_DSH);
    const int lane = F.lane;
    for (int it = gw; it < 2 * DFF + 16 * 256; it += NGW) {
        if (it < 2 * DFF) {
            const u32x4 w0 = *(const u32x4*)(WUP + (size_t)it * D + 8 * lane), w1 = *(const u32x4*)(WUP + (size_t)it * D + 512 + 8 * lane);
            float wf[16];
            wf[0] = __uint_as_float(w0.x << 16); wf[1] = __uint_as_float(w0.x & 0xffff0000u); wf[2] = __uint_as_float(w0.y << 16); wf[3] = __uint_as_float(w0.y & 0xffff0000u);
            wf[4] = __uint_as_float(w0.z << 16); wf[5] = __uint_as_float(w0.z & 0xffff0000u); wf[6] = __uint_as_float(w0.w << 16); wf[7] = __uint_as_float(w0.w & 0xffff0000u);
            wf[8] = __uint_as_float(w1.x << 16); wf[9] = __uint_as_float(w1.x & 0xffff0000u); wf[10] = __uint_as_float(w1.y << 16); wf[11] = __uint_as_float(w1.y & 0xffff0000u);
            wf[12] = __uint_as_float(w1.z << 16); wf[13] = __uint_as_float(w1.z & 0xffff0000u); wf[14] = __uint_as_float(w1.w << 16); wf[15] = __uint_as_float(w1.w & 0xffff0000u);
            float a[4];
#pragma unroll
            for (int b = 0; b < 4; ++b) { const float* sh = mod0 + (size_t)b * NMOD + 3 * D; float t = 0.f;
#pragma unroll
                for (int h = 0; h < 2; ++h) { const f32x4 s0 = *(const f32x4*)(sh + 512 * h + 8 * lane), s1 = *(const f32x4*)(sh + 512 * h + 8 * lane + 4);
                    t += wf[8 * h] * s0.x + wf[8 * h + 1] * s0.y + wf[8 * h + 2] * s0.z + wf[8 * h + 3] * s0.w + wf[8 * h + 4] * s1.x + wf[8 * h + 5] * s1.y + wf[8 * h + 6] * s1.z + wf[8 * h + 7] * s1.w; }
                a[b] = wave_sum(t); }
            if (lane < 4) SHW[(size_t)lane * (2 * DFF) + it] = lane == 0 ? a[0] : lane == 1 ? a[1] : lane == 2 ? a[2] : a[3];
        } else {
            const int o = it - 2 * DFF, bg = o >> 8, r = o & 255, b = bg >> 2, g = bg & 3;
            const u32x2 w = *(const u32x2*)(DC + (size_t)r * 256 + 4 * lane); const f32x4 sv = *(const f32x4*)(mod1 + (size_t)b * NMOD + 0 * D + g * 256 + 4 * lane);
            const float t = wave_sum(__uint_as_float(w.x << 16) * sv.x + __uint_as_float(w.x & 0xffff0000u) * sv.y + __uint_as_float(w.y << 16) * sv.z + __uint_as_float(w.y & 0xffff0000u) * sv.w);
            if (lane == 0) DSH[o] = t;
        }
    }
}

struct SchedIn {
    int G, c; unsigned char* ws;
    __device__ __forceinline__ bool next(int i, pg8::Unit& u) const {
        int L = i * G + c; if (L >= 784) return false;
        const char* H = (const char*)(ws + WS_H); const char* HC = (const char*)(ws + WS_HC); const char* W = (const char*)(ws + WS_WIN);
        int pm, pn; u.row0 = 0; u.col0 = 0;
        if (L < 384) { pg8::grid_unit(L, 6, 64, pm, pn);
            u.a = W + (size_t)pm * 256 * 2048; u.b = H + (size_t)pn * 256 * 2048; u.o = (char*)(ws + WS_HYT) + ((size_t)pm * 256 * NT + pn * 256) * 2; u.ldc = NT; return true; } L -= 384;
        if (L < 256) { pg8::grid_unit(L, 64, 4, pm, pn);
            u.a = H + (size_t)pm * 256 * 2048; u.b = W + (size_t)(1536 + pn * 256) * 2048; u.o = (char*)(ws + WS_QK) + ((size_t)pm * 256 * 1024 + pn * 256) * 2; u.ldc = 1024; return true; } L -= 256;
        if (L < 128) { pg8::grid_unit(L, 2, 64, pm, pn);
            u.a = W + (size_t)(2560 + pm * 256) * 2048; u.b = H + (size_t)pn * 256 * 2048; u.o = (char*)(ws + WS_VT) + ((size_t)pm * 256 * NT + pn * 256) * 2; u.ldc = NT; return true; } L -= 128;
        if (L < 8) { pm = L >> 1; pn = L & 1;
            u.a = HC + (size_t)pm * 256 * 2048; u.b = W + (size_t)(2048 + pn * 256) * 2048; u.o = (char*)(ws + WS_KC) + ((size_t)pm * 256 * 512 + pn * 256) * 2; u.ldc = 512; return true; } L -= 8;
        { pm = L >> 2; pn = L & 3;
            u.a = W + (size_t)(2560 + pm * 256) * 2048; u.b = HC + (size_t)pn * 256 * 2048; u.o = (char*)(ws + WS_VCT) + ((size_t)pm * 256 * NCTX + pn * 256) * 2; u.ldc = NCTX; return true; }
    }
};
struct SchedPlain {
    int G, c, nM, nN; const char* A; const char* B; char* O; int lda, ldb, ldc, ocol, osz;
    __device__ __forceinline__ bool next(int i, pg8::Unit& u) const {
        const int L = i * G + c; if (L >= nM * nN) return false;
        int pm, pn; pg8::grid_unit(L, nM, nN, pm, pn);
        u.a = A + (size_t)pm * 256 * lda * 2; u.b = B + (size_t)pn * 256 * ldb * 2; u.o = O + ((size_t)pm * 256 * ldc + (size_t)pn * ocol) * osz; u.ldc = ldc; u.row0 = pm * 256; u.col0 = pn * 256; u.aux = i; return true;
    }
};
struct SchedChDft {
    int G, c; unsigned char* ws;
    __device__ __forceinline__ bool next(int i, pg8::Unit& u) const {
        const int L = i * G + c; if (L >= 256) return false;
        const int g = L & 3, pn = L >> 2;
        const int b = pn >> 4, t0 = (pn & 15) * 256;
        u.a = (const char*)(ws + WS_DFTCH); u.b = (const char*)(ws + WS_H) + ((size_t)pn * 256 * 1024 + g * 256) * 2;
        u.o = (char*)(ws + WS_PQT) + ((size_t)((b * 4 + g) * 256) * 4096 + t0) * 2; u.ldc = 4096; u.row0 = b * 4 + g; u.col0 = pn * 256; u.aux = i; return true;
    }
};
struct SchedMoe {
    int G, c, nN; int tb[9]; const char* A; const char* B; char* O; int lda, ldb, ldc, ocol; size_t bstride;
    int sparseA;
    int Tuse;
    __device__ __forceinline__ bool next(int i, pg8::Unit& u) const {
        const int L = i * G + c; const int T = Tuse; if (L >= T * nN) return false;
        int pm, pn; pg8::grid_unit(L, T, nN, pm, pn);
        int e = 0;
#pragma unroll
        for (int q = 1; q < 8; ++q) e += (pm >= tb[q]) ? 1 : 0;
        int tbe = 0;
#pragma unroll
        for (int q = 0; q < 8; ++q) tbe = (q == e) ? tb[q] : tbe;
        u.a = A + (sparseA ? ((size_t)e * NT + (size_t)(pm - tbe) * 256) : (size_t)pm * 256) * lda * 2; u.b = B + (size_t)e * bstride + (size_t)pn * 256 * ldb * 2; u.o = O + ((size_t)pm * 256 * ldc + (size_t)pn * ocol) * 2; u.ldc = ldc; u.row0 = pm * 256; u.col0 = pn * 256; return true;
    }
};

constexpr int MOE_MAIN_TILES = 128, MOE_KCH = 7;
struct SchedMoeLeft {
    int G, c; int tb[9]; const char* A; const char* B; char* O; size_t bstride;
    __device__ __forceinline__ bool next(int i, pg8::Unit& u) const {
        const int job = i * G + c; if (job >= (tb[8] - MOE_MAIN_TILES) * 4 * MOE_KCH) return false;
        const int idx = job / MOE_KCH, ch = job - idx * MOE_KCH, pm = MOE_MAIN_TILES + (idx >> 2), pn = idx & 3;
        int e = 0;
#pragma unroll
        for (int q = 1; q < 8; ++q) e += (pm >= tb[q]) ? 1 : 0;
        u.a = A + (size_t)pm * 256 * DFE + ch * (DFE / MOE_KCH); u.b = B + (size_t)e * bstride + (size_t)pn * 256 * DFE + ch * (DFE / MOE_KCH); u.o = O + (size_t)job * (256 * 256 * 4); u.ldc = 256; u.row0 = 0; u.col0 = 0; u.aux = 0; return true;
    }
};

__device__ __forceinline__ f32x4 mfma16(bf16x8 a, bf16x8 b, f32x4 c) { return __builtin_amdgcn_mfma_f32_16x16x32_bf16(a, b, c, 0, 0, 0); }

constexpr int NA_KS = 0, NA_VS = 45056, NA_KCS = 95744, NA_VCS = 112128, NA_RP = 129024, NA_MAXROWS = 11;
template <bool LOCAL> __device__ __forceinline__ void na_half(Frame& F, int lane_, bf16x8 qf, int r, int r0, int krel0, int qcol, int cstart, int bstart, float& mx_out, float& l_out, f32x4& o0, f32x4& o1) {
    const LAS float* rp = (const LAS float*)(F.lds + NA_RP);
    asm volatile("" : "+v"(lane_));
    const int i = lane_ & 15, g = lane_ >> 4;
    const f32x4 zero4 = (f32x4){0.f, 0.f, 0.f, 0.f};
    f32x4 sc[16];
#pragma unroll
    for (int t0 = 0; t0 < 16; t0 += 4) {
        bf16x8 kf[4];
#pragma unroll
        for (int t = 0; t < 4; ++t) { const int tt = t0 + t;
            const int key = LOCAL ? (bstart + 16 * (tt & 1) + i) : (16 * tt + i);
            const int off = (LOCAL ? (NA_KS + (krel0 + (tt >> 1)) * 4096) : NA_KCS) + key * 64 + ((g ^ ((key >> 2) & 3)) << 4);
            kf[t] = *(const LAS bf16x8*)(F.lds + off); }
#pragma unroll
        for (int t = 0; t < 4; ++t) sc[t0 + t] = mfma16(kf[t], qf, zero4);
        __builtin_amdgcn_sched_barrier(0);
    }
    float mx = -1e30f, l = 0.f;
    if (LOCAL) {
        const int w0 = cstart - bstart;
#pragma unroll
        for (int rr = 0; rr < 8; ++rr)
#pragma unroll
            for (int jj = 0; jj < 4; ++jj) { const int pos = 4 * g + jj; const bool lo = pos >= w0;
                const float m = lo ? sc[2 * rr][jj] : sc[2 * rr + 1][jj];
                const float v = m + rp[(r0 + rr - r + 7) * 31 + bstart + pos + (lo ? 0 : 16) - qcol + 15];
                sc[2 * rr][jj] = v; mx = fmaxf(mx, v); }
        mx = fmaxf(mx, __shfl_xor(mx, 16)); mx = fmaxf(mx, __shfl_xor(mx, 32));
#pragma unroll
        for (int rr = 0; rr < 8; ++rr)
#pragma unroll
            for (int jj = 0; jj < 4; ++jj) { const int pos = 4 * g + jj; const bool lo = pos >= w0;
                const float p = __builtin_amdgcn_exp2f(sc[2 * rr][jj] - mx); l += p;
                sc[2 * rr][jj] = lo ? p : 0.f; sc[2 * rr + 1][jj] = lo ? 0.f : p; }
    } else {
#pragma unroll
        for (int tt = 0; tt < 16; ++tt)
#pragma unroll
            for (int jj = 0; jj < 4; ++jj) mx = fmaxf(mx, sc[tt][jj]);
        mx = fmaxf(mx, __shfl_xor(mx, 16)); mx = fmaxf(mx, __shfl_xor(mx, 32));
#pragma unroll
        for (int tt = 0; tt < 16; ++tt)
#pragma unroll
            for (int jj = 0; jj < 4; ++jj) { const float p = __builtin_amdgcn_exp2f(sc[tt][jj] - mx); sc[tt][jj] = p; l += p; }
    }
    l += __shfl_xor(l, 16); l += __shfl_xor(l, 32);
    o0 = zero4; o1 = zero4;
#pragma unroll
    for (int ks = 0; ks < 8; ++ks) {
        union { u32x4 u; bf16x8 v; } pf, v0, v1;
        pf.u.x = pk2(sc[2 * ks][0], sc[2 * ks][1]); pf.u.y = pk2(sc[2 * ks][2], sc[2 * ks][3]); pf.u.z = pk2(sc[2 * ks + 1][0], sc[2 * ks + 1][1]); pf.u.w = pk2(sc[2 * ks + 1][2], sc[2 * ks + 1][3]);
        const int vb = LOCAL ? (NA_VS + ((krel0 + ks) * 32 + i) * 144 + (bstart + 4 * g) * 2) : (NA_VCS + i * 528 + (32 * ks + 4 * g) * 2);
        const int dstep = LOCAL ? 16 * 144 : 16 * 528;
        const u32x2 a = *(const LAS u32x2*)(F.lds + vb), bq = *(const LAS u32x2*)(F.lds + vb + 32), c2 = *(const LAS u32x2*)(F.lds + vb + dstep), d2 = *(const LAS u32x2*)(F.lds + vb + dstep + 32);
        v0.u.x = a.x; v0.u.y = a.y; v0.u.z = bq.x; v0.u.w = bq.y; v1.u.x = c2.x; v1.u.y = c2.y; v1.u.z = d2.x; v1.u.w = d2.y;
        o0 = mfma16(v0.v, pf.v, o0); o1 = mfma16(v1.v, pf.v, o1);
        if ((ks & 1) == 1) __builtin_amdgcn_sched_barrier(0);
    }
    mx_out = mx; l_out = l;
}
__device__ __forceinline__ void na_unit(Frame& F, int b, int h, int r, int j, int krow_lo, const u32x4 qr) {
    bf16* YC = (bf16*)(F.ws + WS_YCAT);
    int lane_ = F.lane; asm volatile("" : "+v"(lane_));
    const int i = lane_ & 15, g = lane_ >> 4;
    const int qcol = 16 * j + i;
    const int cstart = min(max(qcol - 8, 0), 48), bstart = min(max(16 * j - 8, 0), 32), r0 = min(max(r - 4, 0), 56);
    const size_t tokq = (size_t)b * SEQ + r * 64 + qcol;
    bf16x8 qf;
    { const float qs = 0.17677669529663687f * 1.4426950408889634f;
      union { u32x4 u; bf16x8 v; } qq;
      qq.u.x = pk2(__uint_as_float(qr.x << 16) * qs, __uint_as_float(qr.x & 0xffff0000u) * qs); qq.u.y = pk2(__uint_as_float(qr.y << 16) * qs, __uint_as_float(qr.y & 0xffff0000u) * qs);
      qq.u.z = pk2(__uint_as_float(qr.z << 16) * qs, __uint_as_float(qr.z & 0xffff0000u) * qs); qq.u.w = pk2(__uint_as_float(qr.w << 16) * qs, __uint_as_float(qr.w & 0xffff0000u) * qs);
      qf = qq.v; }
    float mA, lA, mB, lB; f32x4 a0, a1, b0, b1;
    na_half<true>(F, lane_, qf, r, r0, r0 - krow_lo, qcol, cstart, bstart, mA, lA, a0, a1);
    na_half<false>(F, lane_, qf, r, r0, r0 - krow_lo, qcol, cstart, bstart, mB, lB, b0, b1);
    const float m = fmaxf(mA, mB), fA = __builtin_amdgcn_exp2f(mA - m), fB = __builtin_amdgcn_exp2f(mB - m);
    const float inv = 1.0f / (lA * fA + lB * fB), ca = fA * inv, cb = fB * inv;
    const f32x4 o0 = a0 * ca + b0 * cb, o1 = a1 * ca + b1 * cb;
    bf16* yo = YC + tokq * 1024 + 512 + h * 32 + 4 * g;
    u32x2 w0, w1; w0.x = pk2(o0[0], o0[1]); w0.y = pk2(o0[2], o0[3]); w1.x = pk2(o1[0], o1[1]); w1.y = pk2(o1[2], o1[3]);
    *(u32x2*)yo = w0; *(u32x2*)(yo + 16) = w1;
}
struct NaRows { u32x4 k[6], v[6]; };
__device__ __forceinline__ void na_rows_load(Frame& F, NaRows& R, const bf16* QK, const bf16* VT, int b, int h, int krow_lo, int nrows) {
#pragma unroll
    for (int i = 0; i < 6; ++i) { const int ch = min(F.tid + NTHR * i, nrows * 256 - 1);
        { const int kr = ch >> 8, key = (ch >> 2) & 63, gq = ch & 3; R.k[i] = *(const u32x4*)(QK + ((size_t)b * SEQ + (krow_lo + kr) * 64 + key) * 1024 + 512 + h * 32 + gq * 8); }
        { const int kr = ch >> 8, d = (ch >> 3) & 31, c = ch & 7; R.v[i] = *(const u32x4*)(VT + (size_t)(h * 32 + d) * NT + (size_t)b * SEQ + (krow_lo + kr) * 64 + 8 * c); } }
}
__device__ __forceinline__ void na_rows_store(Frame& F, const NaRows& R, int nrows) {
#pragma unroll
    for (int i = 0; i < 6; ++i) { const int ch = F.tid + NTHR * i;
        if (ch < nrows * 256) {
            { const int kr = ch >> 8, key = (ch >> 2) & 63, gq = ch & 3; *(LAS u32x4*)(F.lds + NA_KS + kr * 4096 + key * 64 + ((gq ^ ((key >> 2) & 3)) << 4)) = R.k[i]; }
            { const int kr = ch >> 8, d = (ch >> 3) & 31, c = ch & 7; *(LAS u32x4*)(F.lds + NA_VS + (kr * 32 + d) * 144 + c * 16) = R.v[i]; } } }
}
__device__ __forceinline__ void na_task(Frame& F, int task) {
    const int b = task >> 6, h = ((task >> 4) & 3) * 4 + ((task >> 2) & 1) * 2 + ((task >> 3) & 1), quarter = task & 3, tid = F.tid;
    const bf16* QK = (const bf16*)(F.ws + WS_QK); const bf16* VT = (const bf16*)(F.ws + WS_VT);
    const bf16* KC = (const bf16*)(F.ws + WS_KC); const bf16* VCT = (const bf16*)(F.ws + WS_VCT);
    LAS float* rp = (LAS float*)(F.lds + NA_RP);
    const int lane_i = F.lane & 15, lane_g = F.lane >> 4;
    {
        const float rpv = F.in[17][h * 465 + min(tid, 464)];
        u32x4 kc[2], vc[2];
#pragma unroll
        for (int i = 0; i < 2; ++i) { const int ch = tid + NTHR * i;
            { const int key = ch >> 2, gq = ch & 3; kc[i] = *(const u32x4*)(KC + (size_t)(b * CTX + key) * 512 + h * 32 + gq * 8); }
            { const int d = ch >> 5, c = ch & 31; vc[i] = *(const u32x4*)(VCT + (size_t)(h * 32 + d) * NCTX + b * CTX + 8 * c); } }
        __syncthreads();
        if (tid < 465) rp[tid] = rpv * 1.4426950408889634f;
#pragma unroll
        for (int i = 0; i < 2; ++i) { const int ch = tid + NTHR * i;
            { const int key = ch >> 2, gq = ch & 3; *(LAS u32x4*)(F.lds + NA_KCS + key * 64 + ((gq ^ ((key >> 2) & 3)) << 4)) = kc[i]; }
            { const int d = ch >> 5, c = ch & 31; *(LAS u32x4*)(F.lds + NA_VCS + d * 528 + c * 16) = vc[i]; } }
    }
#pragma unroll 1
    for (int ti = 0; ti < 4; ++ti) {
        const int rq = 16 * quarter + 4 * ti;
        const int krow_lo = min(max(rq - 4, 0), 56), krow_hi = min(max(rq + 3 - 4, 0), 56) + 7, nrows = krow_hi - krow_lo + 1;
        const int r = rq + (F.wave >> 1);
        u32x4 qr[2];
        { NaRows R; na_rows_load(F, R, QK, VT, b, h, krow_lo, nrows);
#pragma unroll
          for (int jj = 0; jj < 2; ++jj) qr[jj] = *(const u32x4*)(QK + ((size_t)b * SEQ + r * 64 + 16 * (2 * (F.wave & 1) + jj) + lane_i) * 1024 + h * 32 + 8 * lane_g);
          if (ti > 0) __syncthreads();
          na_rows_store(F, R, nrows); }
        __syncthreads();
        na_unit(F, b, h, r, 2 * (F.wave & 1), krow_lo, qr[0]);
        na_unit(F, b, h, r, 2 * (F.wave & 1) + 1, krow_lo, qr[1]);
    }
    __syncthreads();
}

__device__ __forceinline__ f32x2 cmul(f32x2 a, f32x2 b) {
    f32x2 t, r;
    asm("v_pk_mul_f32 %0, %1, %2 op_sel_hi:[0,1]" : "=v"(t) : "v"(a), "v"(b));
    asm("v_pk_fma_f32 %0, %1, %2, %3 op_sel:[1,1,0] op_sel_hi:[1,0,1] neg_lo:[0,1,0]" : "=v"(r) : "v"(a), "v"(b), "v"(t));
    return r;
}
__device__ __forceinline__ f32x2 cmulc(f32x2 a, f32x2 b) {
    f32x2 t, r;
    asm("v_pk_mul_f32 %0, %1, %2 op_sel_hi:[0,1] neg_hi:[0,1]" : "=v"(t) : "v"(a), "v"(b));
    asm("v_pk_fma_f32 %0, %1, %2, %3 op_sel:[1,1,0] op_sel_hi:[1,0,1]" : "=v"(r) : "v"(a), "v"(b), "v"(t));
    return r;
}
__device__ __forceinline__ f32x2 add_mi(f32x2 a, f32x2 b) { f32x2 r; asm("v_pk_add_f32 %0, %1, %2 op_sel:[0,1] op_sel_hi:[1,0] neg_hi:[0,1]" : "=v"(r) : "v"(a), "v"(b)); return r; }
__device__ __forceinline__ f32x2 add_pi(f32x2 a, f32x2 b) { f32x2 r; asm("v_pk_add_f32 %0, %1, %2 op_sel:[0,1] op_sel_hi:[1,0] neg_lo:[0,1]" : "=v"(r) : "v"(a), "v"(b)); return r; }
template <bool INV> __device__ __forceinline__ void dft4(f32x2& a, f32x2& b, f32x2& c, f32x2& d) {
    const f32x2 t0 = a + c, t1 = a - c, t2 = b + d, t3 = b - d;
    a = t0 + t2; c = t0 - t2;
    b = INV ? add_pi(t1, t3) : add_mi(t1, t3); d = INV ? add_mi(t1, t3) : add_pi(t1, t3);
}
template <bool INV> __device__ __forceinline__ f32x2 tw16(f32x2 v, int e) {
    constexpr float C1 = 0.9238795325112867f, S1 = 0.3826834323650898f, R = 0.7071067811865476f;
    float c, s;
    switch (e) { case 0: return v; case 1: c = C1; s = S1; break; case 2: c = R; s = R; break; case 3: c = S1; s = C1; break;
                 case 4: { const f32x2 z = (f32x2){0.f, 0.f}; return INV ? add_pi(z, v) : add_mi(z, v); }
                 case 6: c = -R; s = R; break; default: c = -C1; s = -S1; break;   }
    const f32x2 w = (f32x2){c, INV ? s : -s};
    return cmul(v, w);
}
template <bool INV> __device__ __forceinline__ void dft16(f32x2 (&x)[16]) {
#pragma unroll
    for (int b = 0; b < 4; ++b) dft4<INV>(x[b], x[4 + b], x[8 + b], x[12 + b]);
#pragma unroll
    for (int b = 1; b < 4; ++b)
#pragma unroll
        for (int c = 1; c < 4; ++c) x[4 * c + b] = tw16<INV>(x[4 * c + b], b * c);
    f32x2 y[16];
#pragma unroll
    for (int c = 0; c < 4; ++c) { f32x2 p0 = x[4 * c + 0], p1 = x[4 * c + 1], p2 = x[4 * c + 2], p3 = x[4 * c + 3]; dft4<INV>(p0, p1, p2, p3); y[c] = p0; y[c + 4] = p1; y[c + 8] = p2; y[c + 12] = p3; }
#pragma unroll
    for (int k = 0; k < 16; ++k) x[k] = y[k];
}
struct HyTw { f32x2 w1, w2, w3, w4, w8; };
#ifndef HY_HALF_BARRIER
#define HY_HALF_BARRIER 1
#endif
struct HBar { LAS unsigned* cnt; unsigned target; };
__device__ __forceinline__ void hbar(HBar& hb, int lane) {
#if HY_HALF_BARRIER
    asm volatile("s_waitcnt lgkmcnt(0)" ::: "memory");
    hb.target += 4u;
    if (lane == 0) (void)__hip_atomic_fetch_add(hb.cnt, 1u, __ATOMIC_RELAXED, __HIP_MEMORY_SCOPE_WORKGROUP);
    while (__hip_atomic_load(hb.cnt, __ATOMIC_RELAXED, __HIP_MEMORY_SCOPE_WORKGROUP) < hb.target) __builtin_amdgcn_s_sleep(1);
    asm volatile("" ::: "memory");
#else
    (void)hb; (void)lane;
    asm volatile("s_waitcnt lgkmcnt(0)" ::: "memory"); __builtin_amdgcn_s_barrier(); asm volatile("" ::: "memory");
#endif
}
__device__ __forceinline__ f32x2 opq(f32x2 v) { float a = v.x, b = v.y; asm volatile("" : "+v"(a), "+v"(b)); return (f32x2){a, b}; }
__device__ __forceinline__ void hy_fwd(f32x2 (&x)[16], LAS f32x2* buf, int p, const HyTw& T, HBar& hb, int lane) {
    hbar(hb, lane);
    dft16<false>(x);
    { const f32x2 w0 = opq(T.w1); f32x2 w = w0;
#pragma unroll
      for (int k = 1; k < 16; ++k) { x[k] = cmul(x[k], w); w = cmul(w, w0); } }
    const int a1 = p + (p >> 4);
#pragma unroll
    for (int k = 0; k < 16; ++k) buf[272 * k + a1] = x[k];
    hbar(hb, lane);
    const int a2 = 272 * (p >> 4) + (p & 15);
#pragma unroll
    for (int k = 0; k < 16; ++k) x[k] = buf[a2 + 17 * k];
    dft16<false>(x);
    { const f32x2 w0 = opq(T.w2); f32x2 w = w0;
#pragma unroll
      for (int k = 1; k < 16; ++k) { x[k] = cmul(x[k], w); w = cmul(w, w0); } }
#pragma unroll
    for (int k = 0; k < 16; ++k) buf[a2 + 17 * k] = x[k];
    hbar(hb, lane);
#pragma unroll
    for (int k = 0; k < 16; ++k) x[k] = buf[17 * p + k];
    dft16<false>(x);
}
__device__ __forceinline__ void hy_inv(f32x2 (&x)[16], LAS f32x2* buf, int p, const HyTw& T, HBar& hb, int lane) {
    dft16<true>(x);
    { const f32x2 w0 = opq(T.w2); f32x2 w = w0;
#pragma unroll
      for (int k = 1; k < 16; ++k) { x[k] = cmulc(x[k], w); w = cmul(w, w0); } }
#pragma unroll
    for (int k = 0; k < 16; ++k) buf[17 * p + k] = x[k];
    hbar(hb, lane);
    const int a2 = 272 * (p >> 4) + (p & 15);
#pragma unroll
    for (int k = 0; k < 16; ++k) x[k] = buf[a2 + 17 * k];
    dft16<true>(x);
    { f32x2 w = opq(T.w3); const f32x2 w4 = opq(T.w4);
#pragma unroll
      for (int k = 0; k < 16; ++k) { x[k] = cmulc(x[k], w); w = cmul(w, w4); } }
#pragma unroll
    for (int k = 0; k < 16; ++k) buf[a2 + 17 * k] = x[k];
    hbar(hb, lane);
    const int a1 = p + (p >> 4);
#pragma unroll
    for (int k = 0; k < 16; ++k) x[k] = buf[272 * k + a1];
    dft16<true>(x);
}
constexpr int HY_BUF0 = 0, HY_BUF1 = 34816, HY_PU = 69632, HY_PG = 102400, HY_RED = 135168;
#define HY_W32 ((f32x2){0.9807852804032304f, -0.19509032201612825f})
__device__ __forceinline__ void hy_stage_short(Frame& F, LAS f32x2* dst, const bf16* row, int bp, float w0, float w1, float w2, float bs) {
    const int n0 = 8 * F.tid;
    float o[2][8];
#pragma unroll
    for (int s2 = 0; s2 < 2; ++s2) { const bf16* r = row + (size_t)(2 * bp + s2) * SEQ + n0;
        const u32x4 ch = *(const u32x4*)r;
        const bf16 lraw = r[n0 > 0 ? -1 : 0], rraw = r[n0 + 8 < SEQ ? 8 : 7];
        const float lft = bf2f(lraw) * (n0 > 0 ? 1.0f : 0.0f), rgt = bf2f(rraw) * (n0 + 8 < SEQ ? 1.0f : 0.0f);
        float z[10]; z[0] = lft; z[9] = rgt;
        z[1] = __uint_as_float(ch.x << 16); z[2] = __uint_as_float(ch.x & 0xffff0000u); z[3] = __uint_as_float(ch.y << 16); z[4] = __uint_as_float(ch.y & 0xffff0000u);
        z[5] = __uint_as_float(ch.z << 16); z[6] = __uint_as_float(ch.z & 0xffff0000u); z[7] = __uint_as_float(ch.w << 16); z[8] = __uint_as_float(ch.w & 0xffff0000u);
#pragma unroll
        for (int e = 0; e < 8; ++e) o[s2][e] = w0 * z[e] + w1 * z[e + 1] + w2 * z[e + 2] + bs; }
#pragma unroll
    for (int e = 0; e < 8; e += 2) *(LAS f32x4*)(dst + n0 + e) = (f32x4){o[0][e], o[1][e], o[0][e + 1], o[1][e + 1]};
}
__device__ __forceinline__ void hyena_task(Frame& F, int c) {
    const int tid = F.tid, hs = tid >> 8; int p = tid & 255;
    asm volatile("" : "+v"(p));
    LAS f32x2* buf = (LAS f32x2*)(F.lds + (hs ? HY_BUF1 : HY_BUF0));
    LAS f32x2* buf1 = (LAS f32x2*)(F.lds + HY_BUF1);
    LAS f32x2* PU = (LAS f32x2*)(F.lds + HY_PU); LAS f32x2* PG = (LAS f32x2*)(F.lds + HY_PG);
    LAS float* red = (LAS float*)(F.lds + HY_RED);
    const bf16* HYT = (const bf16*)(F.ws + WS_HYT); const float* KT = (const float*)(F.ws + WS_KT); bf16* YT = (bf16*)(F.ws + WS_YT) + (size_t)c * NT;
    HBar hb; hb.cnt = (LAS unsigned*)(F.lds + HY_RED + 64) + hs; hb.target = 0u;
    __syncthreads();
    if (tid < 2) ((LAS unsigned*)(F.lds + HY_RED + 64))[tid] = 0u;
    __syncthreads();
    f32x2* Y0 = (f32x2*)(F.ws + WS_H2) + (size_t)c * 2 * SEQ;
    HyTw T;
    { float sn, cs; sincosf((float)p * (6.283185307179586f / 4096.0f), &sn, &cs); T.w1 = (f32x2){cs, -sn};
      sincosf((float)(p & 15) * (6.283185307179586f / 256.0f), &sn, &cs); T.w2 = (f32x2){cs, -sn};
      sincosf((float)((p & 15) * (p >> 4)) * (6.283185307179586f / 4096.0f), &sn, &cs); T.w3 = (f32x2){cs, -sn};
      sincosf((float)(p >> 4) * (6.283185307179586f / 256.0f), &sn, &cs); T.w4 = (f32x2){cs, -sn};
      sincosf((float)p * (6.283185307179586f / 8192.0f), &sn, &cs); T.w8 = (f32x2){cs, -sn}; }
    const float* SW = F.in[8]; const float* SB = F.in[9];
#pragma unroll
    for (int o = 0; o < 2; ++o) {
        const int ucol = c, gcol = (o == 0 ? 512 : 1024) + c;
        const float uw0 = SW[ucol], uw1 = SW[1536 + ucol], uw2 = SW[3072 + ucol], ubs = SB[ucol];
        const float gw0 = SW[gcol], gw1 = SW[1536 + gcol], gw2 = SW[3072 + gcol], gbs = SB[gcol];
        const float skip = F.in[16][o * 512 + c];
        f32x2 x[16], Kh[16];
        asm volatile("" : "+v"(p));
        { const float* kf = KT + ((size_t)(o * 2 + 0) * 512 + c) * 4096; const float* kb = KT + ((size_t)(o * 2 + 1) * 512 + c) * 4096;
          float l1 = 0.f; f32x2 w = opq(T.w8);
#pragma unroll
          for (int q = 0; q < 16; ++q) { const int n = p + 256 * q; const float f = kf[n]; const float bk = kb[n >= 1 ? 4096 - n : 0] * (n >= 1 ? 1.0f : 0.0f); l1 += fabsf(f) + fabsf(bk);
              if (hs == 0) x[q] = (f32x2){f + bk, 0.f}; else { const float dlt = f - bk; x[q] = (f32x2){dlt * w.x, dlt * w.y}; }
              w = cmul(w, HY_W32); }
          l1 = wave_sum(l1);
          __syncthreads();
          if (F.lane == 0) red[F.wave] = l1;
          hy_fwd(x, buf, p, T, hb, F.lane);
          const float tot = red[4 * hs] + red[4 * hs + 1] + red[4 * hs + 2] + red[4 * hs + 3];
          const float scl = 1.0f / ((tot + EPS) * 8192.0f);
#pragma unroll
          for (int k = 0; k < 16; ++k) Kh[k] = x[k] * scl; }
#pragma unroll 1
        for (int bp = 0; bp < 2; ++bp) {
            asm volatile("" : "+v"(p));
            __syncthreads();
            if (o == 0) hy_stage_short(F, PU, HYT + (size_t)ucol * NT, bp, uw0, uw1, uw2, ubs);
            else { const f32x4* src = (const f32x4*)(Y0 + (size_t)bp * SEQ + 8 * tid);
#pragma unroll
                for (int e = 0; e < 4; ++e) *(LAS f32x4*)(PU + 8 * tid + 2 * e) = src[e]; }
            hy_stage_short(F, PG, HYT + (size_t)gcol * NT, bp, gw0, gw1, gw2, gbs);
            __syncthreads();
            asm volatile("" : "+v"(p));
            { f32x2 w = opq(T.w8);
#pragma unroll
              for (int q = 0; q < 16; ++q) { const f32x2 u = PU[p + 256 * q]; x[q] = (hs == 0) ? u : cmul(u, w); w = cmul(w, HY_W32); } }
            hy_fwd(x, buf, p, T, hb, F.lane);
#pragma unroll
            for (int k = 0; k < 16; ++k) x[k] = cmul(x[k], Kh[k]);
            hy_inv(x, buf, p, T, hb, F.lane);
            asm volatile("" : "+v"(p));
            if (hs == 1) { f32x2 w = opq(T.w8);
#pragma unroll
                for (int q = 0; q < 16; ++q) { const int n = p + 256 * q; buf1[n + (n >> 4)] = cmulc(x[q], w); w = cmul(w, HY_W32); }
            }
            __syncthreads();
            asm volatile("" : "+v"(p));
            if (hs == 0) {
#pragma unroll
                for (int q = 0; q < 16; ++q) { const int n = p + 256 * q; const f32x2 conv = x[q] + buf1[n + (n >> 4)];
                    const f32x2 yv = (conv + PU[n] * skip) * PG[n];
                    if (o == 0) Y0[(size_t)bp * SEQ + n] = yv;
                    else { YT[(size_t)(2 * bp) * SEQ + n] = (bf16)(pk2(yv.x, 0.f) & 0xffffu); YT[(size_t)(2 * bp + 1) * SEQ + n] = (bf16)(pk2(yv.y, 0.f) & 0xffffu); } }
                if (o == 0) asm volatile("s_waitcnt vmcnt(0)" ::: "memory");
            }
        }
    }
    __syncthreads();
}

__device__ __forceinline__ void yt_transpose(Frame& F) {
    const bf16* YT = (const bf16*)(F.ws + WS_YT); bf16* YC = (bf16*)(F.ws + WS_YCAT);
    LAS bf16* til = (LAS bf16*)(F.lds + F.wave * 8448);
    const int lane = F.lane;
    __syncthreads();
    for (int it = F.bid * NWAVES + F.wave; it < 8 * 256; it += F.G * NWAVES) {
        const int c0 = (it & 7) * 64, t0 = (it >> 3) * 64;
        u32x4 v[8];
#pragma unroll
        for (int i = 0; i < 8; ++i) { const int cr = 8 * i + (lane >> 3), ck = lane & 7; v[i] = *(const u32x4*)(YT + (size_t)(c0 + cr) * NT + t0 + 8 * ck); }
#pragma unroll
        for (int i = 0; i < 8; ++i) { const int cr = 8 * i + (lane >> 3), ck = lane & 7; LAS unsigned* d = (LAS unsigned*)(til + cr * 66 + 8 * ck); d[0] = v[i].x; d[1] = v[i].y; d[2] = v[i].z; d[3] = v[i].w; }
        LDS_WAIT(); asm volatile("" ::: "memory");
#pragma unroll
        for (int i = 0; i < 8; ++i) { const int tr = 8 * i + (lane >> 3), ck = lane & 7;
            const LAS bf16* sp = til + (8 * ck) * 66 + tr;
            u32x4 o; o.x = (unsigned)sp[0] | ((unsigned)sp[66] << 16); o.y = (unsigned)sp[2 * 66] | ((unsigned)sp[3 * 66] << 16); o.z = (unsigned)sp[4 * 66] | ((unsigned)sp[5 * 66] << 16); o.w = (unsigned)sp[6 * 66] | ((unsigned)sp[7 * 66] << 16);
            *(u32x4*)(YC + (size_t)(t0 + tr) * 1024 + c0 + 8 * ck) = o; }
        LDS_WAIT(); asm volatile("" ::: "memory");
    }
}

__device__ __forceinline__ void seqfft_phase(Frame& F) {
    const int tid = F.tid, hs = tid >> 8; int p = tid & 255;
    asm volatile("" : "+v"(p));
    LAS f32x2* buf = (LAS f32x2*)(F.lds + (hs ? HY_BUF1 : HY_BUF0));
    LAS bf16* stg = (LAS bf16*)(F.lds + 69632);
    LAS bf16* stgI = (LAS bf16*)(F.lds + 69632 + 65536 + 256);
    const bf16* PQ = (const bf16*)(F.ws + WS_PQT); bf16* Y = (bf16*)(F.ws + WS_Y);
    HBar hb; hb.cnt = (LAS unsigned*)(F.lds + 69632 + 65536 + 64) + hs; hb.target = 0u;
    __syncthreads();
    if (tid < 2) ((LAS unsigned*)(F.lds + 69632 + 65536 + 64))[tid] = 0u;
    __syncthreads();
    HyTw T;
    { float sn, cs; sincosf((float)p * (6.283185307179586f / 4096.0f), &sn, &cs); T.w1 = (f32x2){cs, -sn};
      sincosf((float)(p & 15) * (6.283185307179586f / 256.0f), &sn, &cs); T.w2 = (f32x2){cs, -sn};
      T.w3 = T.w1; T.w4 = T.w2; T.w8 = T.w1; }
    for (int task = F.bid; task < 256; task += F.G) {
        const int bg = (task & 7) + 8 * (task >> 7), m = (task >> 3) & 15, b = bg >> 2, g = bg & 3;
        const bf16* base = PQ + (size_t)bg * 256 * 4096;
        unsigned short rp[16], rq[16];
        { const int k = 8 * m + 1 + hs; const bf16* Pr = base + (size_t)k * 4096 + p; const bf16* Qr = base + (size_t)(k < 128 ? 128 + k : 0) * 4096 + p;
#pragma unroll
          for (int q = 0; q < 16; ++q) { rp[q] = Pr[256 * q]; rq[q] = Qr[256 * q]; } }
#pragma unroll 1
        for (int s = 0; s < 4; ++s) {
            asm volatile("" : "+v"(p));
            const int j = 2 * s + hs, k = 8 * m + 1 + j;
            const float qs = (k < 128) ? -1.0f : 1.0f;
            f32x2 x[16];
#pragma unroll
            for (int q = 0; q < 16; ++q) x[q] = (f32x2){bf2f(rp[q]), qs * bf2f(rq[q])};
            if (s < 3) { const int kn = k + 2; const bf16* Pr = base + (size_t)kn * 4096 + p; const bf16* Qr = base + (size_t)(kn < 128 ? 128 + kn : 0) * 4096 + p;
#pragma unroll
                for (int q = 0; q < 16; ++q) { rp[q] = Pr[256 * q]; rq[q] = Qr[256 * q]; } }
            hy_fwd(x, buf, p, T, hb, F.lane);
#pragma unroll
            for (int k2 = 0; k2 < 16; ++k2) stg[(k2 * 256 + p) * 8 + j] = (bf16)(pk2(x[k2].x * (1.0f / 64.0f), 0.f) & 0xffffu);
            if (k == 128) {
#pragma unroll
                for (int k2 = 0; k2 < 16; ++k2) stgI[k2 * 256 + p] = (bf16)(pk2(x[k2].y * (1.0f / 64.0f), 0.f) & 0xffffu); }
        }
        __syncthreads();
#pragma unroll 2
        for (int jj = 0; jj < 8; ++jj) { const int e = tid + 512 * jj, f = ((e & 255) >> 4) + 16 * (e & 15) + 256 * (e >> 8);
            const int fm = (4096 - f) & 4095, em = (fm >> 8) * 256 + (fm & 15) * 16 + ((fm >> 4) & 15);
            u32x4 d = *(const LAS u32x4*)(stg + e * 8), dm = *(const LAS u32x4*)(stg + em * 8);
            bf16* yr = Y + ((size_t)(b * SEQ + f)) * 1024 + g * 256;
            if (m == 15) {
                const float c128 = 0.5f * (__uint_as_float(d.w & 0xffff0000u) + __uint_as_float(dm.w & 0xffff0000u));
                const unsigned h = pk2(c128, 0.f) & 0xffffu, h0 = pk2(0.5f * (bf2f(stgI[e]) + bf2f(stgI[em])), 0.f) & 0xffffu;
                d.w = (d.w & 0xffffu) | (h << 16); dm.w = (dm.w & 0xffffu) | (h0 << 16); }
            *(u32x4*)(yr + 16 * m) = d; *(u32x4*)(yr + 16 * m + 8) = dm; }
        __syncthreads();
    }
}

__device__ __forceinline__ void route_phase(Frame& F, const bf16* X, const float* g, const float* mod) {
    LAS float* gs = (LAS float*)(F.lds);
    LAS float* sv = (LAS float*)(F.lds + 16384);
    LAS unsigned char* stage = F.lds + 32768;
    LAS unsigned* rinfo = (LAS unsigned*)(F.lds + 98304);
    LAS unsigned* lcnt = (LAS unsigned*)(F.lds + 100352);
    { float tg[8], ts[8], th[8];
#pragma unroll
      for (int q = 0; q < 8; ++q) { const int i = F.tid + NTHR * q, b = i >> 10, k = i & 1023; tg[q] = g[k]; ts[q] = mod[(size_t)b * NMOD + 4 * D + k]; th[q] = mod[(size_t)b * NMOD + 3 * D + k]; }
#pragma unroll
      for (int q = 0; q < 8; ++q) { const int i = F.tid + NTHR * q; gs[i] = tg[q] * (1.0f + ts[q]); sv[i] = th[q]; } }
    __syncthreads();
    const float* WR = F.in[23]; const float* BR = F.in[24];
    unsigned char* ACS = F.ws + WS_ACS; unsigned* ctl = (unsigned*)(F.ws + WS_CTL); unsigned* RT = (unsigned*)(F.ws + WS_ROUTE);
    for (int blk = F.bid; blk < NT / 64; blk += F.G) {
        if (F.tid < 8) lcnt[F.tid] = 0u;
        __syncthreads();
#pragma unroll 1
        for (int rw = 0; rw < 8; ++rw) {
            const int rl = F.wave * 8 + rw, row = blk * 64 + rl;
            const int b = row >> 12; const bf16* xr = X + (size_t)row * D;
            f32x4 v[4]; float s = 0.f;
#pragma unroll
            for (int j = 0; j < 4; ++j) { const u32x2 q = *((const u32x2*)xr + F.lane + 64 * j); v[j] = (f32x4){__uint_as_float(q.x << 16), __uint_as_float(q.x & 0xffff0000u), __uint_as_float(q.y << 16), __uint_as_float(q.y & 0xffff0000u)};
                s += (v[j].x * v[j].x + v[j].y * v[j].y) + (v[j].z * v[j].z + v[j].w * v[j].w); }
            const float rstd = 1.0f / sqrtf(wave_sum(s) * (1.0f / D) + EPS);
            f32x2 lgp[4];
#pragma unroll
            for (int e = 0; e < 4; ++e) lgp[e] = (f32x2){0.f, 0.f};
#pragma unroll
            for (int j = 0; j < 4; ++j) { const int k = 4 * F.lane + 256 * j; const f32x4 a = *(const LAS f32x4*)(gs + b * 1024 + k), c = *(const LAS f32x4*)(sv + b * 1024 + k);
                const f32x4 o = v[j] * rstd * a + c;
                *(LAS unsigned*)(stage + rl * 1024 + k) = pg8::pk4_fp8(o.x * H8_SCALE, o.y * H8_SCALE, o.z * H8_SCALE, o.w * H8_SCALE);
#pragma unroll
                for (int q = 0; q < 4; ++q) { const f32x4 w0 = *(const f32x4*)(WR + (size_t)(k + q) * 8), w1 = *(const f32x4*)(WR + (size_t)(k + q) * 8 + 4);
                    const f32x2 ob = (f32x2){o[q], o[q]};
                    lgp[0] = __builtin_elementwise_fma(ob, (f32x2){w0.x, w0.y}, lgp[0]); lgp[1] = __builtin_elementwise_fma(ob, (f32x2){w0.z, w0.w}, lgp[1]);
                    lgp[2] = __builtin_elementwise_fma(ob, (f32x2){w1.x, w1.y}, lgp[2]); lgp[3] = __builtin_elementwise_fma(ob, (f32x2){w1.z, w1.w}, lgp[3]); } }
            float lg[8];
#pragma unroll
            for (int e = 0; e < 4; ++e) { lg[2 * e] = wave_sum(lgp[e].x) + BR[2 * e]; lg[2 * e + 1] = wave_sum(lgp[e].y) + BR[2 * e + 1]; }
            int ea = 0; float va = lg[0];
#pragma unroll
            for (int e = 1; e < 8; ++e) if (lg[e] > va) { va = lg[e]; ea = e; }
            int eb = -1; float vb = -3.0e38f;
#pragma unroll
            for (int e = 0; e < 8; ++e) if (e != ea && lg[e] > vb) { vb = lg[e]; eb = e; }
            const float pb = __expf(vb - va), wa = 1.0f / (1.0f + pb), wb = pb * wa;
            if (F.lane == 0) { const unsigned la = __hip_atomic_fetch_add(lcnt + ea, 1u, __ATOMIC_RELAXED, __HIP_MEMORY_SCOPE_WORKGROUP), lb = __hip_atomic_fetch_add(lcnt + eb, 1u, __ATOMIC_RELAXED, __HIP_MEMORY_SCOPE_WORKGROUP);
                LAS unsigned* ri = rinfo + rl * 8; ri[0] = (unsigned)ea; ri[1] = (unsigned)eb; ri[2] = __float_as_uint(wa); ri[3] = __float_as_uint(wb); ri[4] = la; ri[5] = lb; }
        }
        __syncthreads();
        if (F.tid < 8) lcnt[8 + F.tid] = xb_add(ctl + CW_CNT + 64 * F.tid, lcnt[F.tid]);
        __syncthreads();
#pragma unroll 1
        for (int rw = 0; rw < 8; ++rw) {
            const int rl = F.wave * 8 + rw, row = blk * 64 + rl;
            const LAS unsigned* ri = rinfo + rl * 8;
            const unsigned ea = ri[0], eb = ri[1], sa = lcnt[8 + ea] + ri[4], sb = lcnt[8 + eb] + ri[5];
            const u32x4 d = *(const LAS u32x4*)(stage + rl * 1024 + 16 * F.lane);
            *((u32x4*)(ACS + ((size_t)ea * NT + sa) * D) + F.lane) = d; *((u32x4*)(ACS + ((size_t)eb * NT + sb) * D) + F.lane) = d;
            if (F.lane == 0) { u32x4 r; r.x = (ea << 24) | sa; r.y = (eb << 24) | sb; r.z = ri[2]; r.w = ri[3]; *(u32x4*)(RT + (size_t)row * 4) = r; }
        }
        __syncthreads();
    }
}
__device__ __forceinline__ void moe_tiles(Frame& F, int (&tb)[9]) {
    unsigned* ctl = (unsigned*)(F.ws + WS_CTL); int acc = 0;
#pragma unroll
    for (int e = 0; e < 8; ++e) { tb[e] = acc; acc += ((int)xb_ld(ctl + CW_CNT + 64 * e) + 255) >> 8; }
    tb[8] = acc;
}
struct FinRow { u32x2 x[4], a[4], b[4]; f32x4 g[4]; int cra, crb; };
__device__ __forceinline__ void fin_load(Frame& F, FinRow& R, const int (&tb)[9], const u32x4 r, int row, const float* mod) {
    const bf16* SL = (const bf16*)(F.ws + WS_ACOMP); const bf16* xb = (const bf16*)(F.ws + WS_RB) + (size_t)row * D; const float* gt = mod + (size_t)(row >> 12) * NMOD + 5 * D;
    const int ea = r.x >> 24, eb = r.y >> 24; int ba = 0, bb = 0;
#pragma unroll
    for (int e = 0; e < 8; ++e) { ba = (e == ea) ? tb[e] : ba; bb = (e == eb) ? tb[e] : bb; }
    R.cra = ba * 256 + (int)(r.x & 0xffffffu); R.crb = bb * 256 + (int)(r.y & 0xffffffu);
    const bf16* sa = SL + (size_t)R.cra * D; const bf16* sb = SL + (size_t)R.crb * D;
#pragma unroll
    for (int j = 0; j < 4; ++j) { const int k = 4 * F.lane + 256 * j; R.x[j] = *(const u32x2*)(xb + k); R.a[j] = *(const u32x2*)(sa + k); R.b[j] = *(const u32x2*)(sb + k); R.g[j] = *(const f32x4*)(gt + k); }
}
__device__ __forceinline__ void final_phase(Frame& F, const float* mod, const int (&tb)[9]) {
    const unsigned* RT = (const unsigned*)(F.ws + WS_ROUTE); const float* fg = F.in[28]; const float* PART = (const float*)(F.ws + WS_ACS);
    const int gw = F.bid * NWAVES + F.wave, NGW = F.G * NWAVES;
    if (gw >= NT) return;
    f32x4 fgv[4];
#pragma unroll
    for (int j = 0; j < 4; ++j) fgv[j] = *(const f32x4*)(fg + 4 * F.lane + 256 * j);
    u32x4 rc = *(const u32x4*)(RT + (size_t)gw * 4), rn = *(const u32x4*)(RT + (size_t)min(gw + NGW, NT - 1) * 4);
    FinRow C, N;
    fin_load(F, C, tb, rc, gw, mod);
#pragma unroll 1
    for (int row = gw; row < NT; row += NGW) {
        const int nx = row + NGW; const bool hn = nx < NT;
        const float wa = __uint_as_float(rc.z), wb = __uint_as_float(rc.w);
        const u32x4 rnn = *(const u32x4*)(RT + (size_t)min(nx + NGW, NT - 1) * 4);
        if (hn) fin_load(F, N, tb, rn, nx, mod);
        float* xr = F.out + (size_t)row * D;
        f32x4 v[4]; float s = 0.f;
#pragma unroll
        for (int j = 0; j < 4; ++j) { const u32x2 xq = C.x[j], ua = C.a[j], ub = C.b[j];
            const f32x4 xv = (f32x4){__uint_as_float(xq.x << 16), __uint_as_float(xq.x & 0xffff0000u), __uint_as_float(xq.y << 16), __uint_as_float(xq.y & 0xffff0000u)};
            f32x4 ma, mb; ma.x = __uint_as_float(ua.x << 16); ma.y = __uint_as_float(ua.x & 0xffff0000u); ma.z = __uint_as_float(ua.y << 16); ma.w = __uint_as_float(ua.y & 0xffff0000u);
            mb.x = __uint_as_float(ub.x << 16); mb.y = __uint_as_float(ub.x & 0xffff0000u); mb.z = __uint_as_float(ub.y << 16); mb.w = __uint_as_float(ub.y & 0xffff0000u);
            if (C.cra >= MOE_MAIN_TILES * 256) { const float* pp = PART + ((size_t)((((C.cra >> 8) - MOE_MAIN_TILES) * 4 + j) * MOE_KCH) * 256 + (C.cra & 255)) * 256 + 4 * F.lane; ma = *(const f32x4*)pp;
#pragma unroll
                for (int c = 1; c < MOE_KCH; ++c) ma += *(const f32x4*)(pp + (size_t)c * 65536); }
            if (C.crb >= MOE_MAIN_TILES * 256) { const float* pp = PART + ((size_t)((((C.crb >> 8) - MOE_MAIN_TILES) * 4 + j) * MOE_KCH) * 256 + (C.crb & 255)) * 256 + 4 * F.lane; mb = *(const f32x4*)pp;
#pragma unroll
                for (int c = 1; c < MOE_KCH; ++c) mb += *(const f32x4*)(pp + (size_t)c * 65536); }
            v[j] = xv + C.g[j] * (ma * wa + mb * wb); s += (v[j].x * v[j].x + v[j].y * v[j].y) + (v[j].z * v[j].z + v[j].w * v[j].w); }
        const float rstd = 1.0f / sqrtf(wave_sum(s) * (1.0f / D) + EPS);
#pragma unroll
        for (int j = 0; j < 4; ++j) { const int k = 4 * F.lane + 256 * j; *(f32x4*)(xr + k) = v[j] * rstd * fgv[j]; }
        if (hn) {
#pragma unroll
            for (int j = 0; j < 4; ++j) { C.x[j] = N.x[j]; C.a[j] = N.a[j]; C.b[j] = N.b[j]; C.g[j] = N.g[j]; } C.cra = N.cra; C.crb = N.crb; }
        rc = rn; rn = rnn;
    }
}
constexpr int NPHASE = 18;
struct Args { const float* in[29]; float* out; unsigned char* ws; int ph_lo, ph_hi; };
__global__ void __launch_bounds__(NTHR, 2) mk_fwd(Args args) {
    extern __shared__ __attribute__((aligned(16))) unsigned char lds_raw[];
    Frame F;
    F.lds = (LAS unsigned char*)lds_raw;
    F.tid = threadIdx.x; F.lane = F.tid & 63; F.wave = __builtin_amdgcn_readfirstlane(F.tid >> 6);
    F.G = gridDim.x; F.bid = blockIdx.x; F.out = args.out; F.ws = args.ws; F.in = args.in;
    volatile LAS unsigned* MISC = (volatile LAS unsigned*)(F.lds + MISC_OFF);
    if (F.tid < 32) MISC[F.tid] = 0u;
    __syncthreads();
    unsigned* ctl = (unsigned*)(F.ws + WS_CTL);
    XcdBarrier bar; bar.bar = ctl + CW_BAR; bar.x = 0; bar.st = nullptr;
    const int lo = args.ph_lo, hi = args.ph_hi;
    if (hi - lo > 1) bar = xcd_barrier_post(ctl + CW_BAR, MISC + 8);
#ifndef PH_MASK
#define PH_MASK 0x3ffff
#endif
#define IN(k) (((PH_MASK >> (k)) & 1) && lo <= (k) && (k) < hi)
#define SEAM(k) do { if (IN(k) && IN((k) + 1)) xcd_barrier(bar); } while (0)
    const float* MOD0 = (const float*)(F.ws + WS_MOD); const float* MOD1 = MOD0 + 5 * NMOD;
    unsigned char* ws = F.ws;
    bf16* RB = (bf16*)(ws + WS_RB); u64* SS0 = (u64*)(ctl + CW_SS); u64* SS1 = SS0 + NT;

    if (IN(0)) { p0_prologue(F); }
    if (IN(0) && IN(1)) {
        if (F.tid == 0) { unsigned sp = 0u; while (xb_ld(ctl + CW_FLAG) < 32u) { __builtin_amdgcn_s_sleep(4); if (++sp > (1u << 22)) break; }
            __builtin_amdgcn_fence(__ATOMIC_ACQUIRE, "agent"); asm volatile("s_waitcnt vmcnt(0)" ::: "memory"); }
        __syncthreads(); }
    if (IN(1)) { norm_phase(F, F.in[0], NT, (bf16*)(ws + WS_H), F.in[2], NCTX, (bf16*)(ws + WS_HC), F.in[6], MOD0, 0, 1); } SEAM(1);
    if (IN(2)) { pg8::Gemm g{D, D, D}; SchedIn S{F.G, F.bid, ws}; pg8::EpiBf16 E{1.0f}; pg8::gemm_phase<pg8::EpiBf16, SchedIn>(F.lds, g, S, E);
        moe_tail_convert(F, 784, CV_ITEMS - MOE_DEFER_P2 - MOE_DEFER_P6, CV_ITEMS - MOE_DEFER_P6);
        { const int rem = 784 % F.G;
          if (rem == 0) shift_gemvs(F, MOD0, MOD1, F.bid * NWAVES + F.wave, F.G * NWAVES);
          else if (F.bid >= rem) shift_gemvs(F, MOD0, MOD1, (F.bid - rem) * NWAVES + F.wave, (F.G - rem) * NWAVES); } } SEAM(2);
    if (IN(3)) {
        for (int c = F.bid; c < CH; c += F.G) hyena_task(F, c);
    } SEAM(3);
    if (IN(4)) {
        for (int t = F.bid; t < 256; t += F.G) na_task(F, t);
        yt_transpose(F);
    } SEAM(4);
    if (IN(5)) { pg8::Gemm g{D, D, D}; SchedPlain S{F.G, F.bid, 64, 4, (const char*)(ws + WS_YCAT), (const char*)(ws + WS_WMIX), nullptr, D, D, 0, 0, 0};
        EpiResN<true, true> E{F.in[0], nullptr, RB, (bf16*)(ws + WS_H), MOD0 + 2 * D, F.in[6] + D, MOD0 + 4 * D, SS0}; pg8::gemm_phase<EpiResN<true, true>, SchedPlain>(F.lds, g, S, E); } SEAM(5);
    if (IN(7)) { pg8::Gemm g{D, D, D}; SchedPlain S{F.G, F.bid, 64, 22, (const char*)(ws + WS_H), (const char*)(ws + WS_WUP), (char*)(ws + WS_ACT), D, D, DFF, 128, 2};
        LAS float* rsl = (LAS float*)(F.lds + RING_BYTES);
        { int r0[6];
#pragma unroll
          for (int i = 0; i < 6; ++i) { pg8::Unit u; u.row0 = 0; r0[i] = S.next(i, u) ? u.row0 : -1; }
          if (F.tid < 256) { float v[6];
#pragma unroll
              for (int i = 0; i < 6; ++i) v[i] = ld_ss(SS0 + (r0[i] < 0 ? 0 : r0[i]) + F.tid);
#pragma unroll
              for (int i = 0; i < 6; ++i) if (r0[i] >= 0) rsl[i * 256 + F.tid] = 1.0f / sqrtf(v[i] * (1.0f / D) + EPS); } }
        __syncthreads();
        EpiSwiGLUN E{rsl, (const float*)(ws + WS_SHW)}; pg8::gemm_phase<EpiSwiGLUN, SchedPlain>(F.lds, g, S, E);
        moe_tail_convert(F, 64 * 22, CV_ITEMS - MOE_DEFER_P6, CV_ITEMS); } SEAM(7);
    if (IN(8)) { pg8::Gemm g{DFF, DFF, DFF}; SchedPlain S{F.G, F.bid, 64, 4, (const char*)(ws + WS_ACT), (const char*)(ws + WS_WDN), nullptr, DFF, DFF, 0, 0, 0};
        EpiResN<false, true> E{nullptr, RB, RB, (bf16*)(ws + WS_H), MOD0 + 5 * D, F.in[6] + 2 * D, MOD1 + 1 * D, SS1}; pg8::gemm_phase<EpiResN<false, true>, SchedPlain>(F.lds, g, S, E); } SEAM(8);
    if (IN(10)) { pg8::Gemm g{256, D, 256}; SchedChDft S{F.G, F.bid, ws};     LAS float* rsl = (LAS float*)(F.lds + RING_BYTES);
        for (int i = 0; ; ++i) { pg8::Unit u; if (!S.next(i, u)) break; if (F.tid < 256) rsl[i * 256 + F.tid] = 1.0f / sqrtf(ld_ss(SS1 + u.col0 + F.tid) * (1.0f / D) + EPS); }
        __syncthreads();
        EpiDftN E{rsl, (const float*)(ws + WS_DSH)}; pg8::gemm_phase<EpiDftN, SchedChDft>(F.lds, g, S, E); } SEAM(10);
    if (IN(11)) { seqfft_phase(F); } SEAM(11);
    if (IN(12)) { pg8::Gemm g{D, D, D}; SchedPlain S{F.G, F.bid, 64, 4, (const char*)(ws + WS_Y), (const char*)(ws + WS_WFOU), nullptr, D, D, 0, 0, 0};
        EpiResN<false, false> E{nullptr, RB, RB, nullptr, MOD1 + 2 * D, nullptr, nullptr, nullptr}; pg8::gemm_phase<EpiResN<false, false>, SchedPlain>(F.lds, g, S, E); } SEAM(12);
    if (IN(13)) { route_phase(F, RB, F.in[6] + 3 * D, MOD1); } SEAM(13);
    int tbv[9];
    if (IN(15) || IN(16) || IN(17)) moe_tiles(F, tbv);
    if (IN(15)) { pg8::Gemm g{D / 2, D / 2, D / 2}; SchedMoe S; S.G = F.G; S.c = F.bid; S.nN = 28;
#pragma unroll
        for (int q = 0; q < 9; ++q) S.tb[q] = tbv[q]; S.Tuse = S.tb[8]; S.A = (const char*)(ws + WS_ACS); S.B = (const char*)(ws + WS_MOEUP); S.O = (char*)(ws + WS_MACT); S.sparseA = 1;
        S.lda = D / 2; S.ldb = D / 2; S.ldc = DFE / 2; S.ocol = 64; S.bstride = (size_t)2 * DFE * D;
        pg8::EpiSwiGLU8 E{1.0f / (H8_SCALE * W8_SCALE), A8_SCALE}; pg8::gemm_phase<pg8::EpiSwiGLU8, SchedMoe>(F.lds, g, S, E); } SEAM(15);
    if (IN(16)) { pg8::Gemm g{DFE / 2, DFE / 2, DFE / 2}; SchedMoe S; S.G = F.G; S.c = F.bid; S.nN = 4;
#pragma unroll
        for (int q = 0; q < 9; ++q) S.tb[q] = tbv[q]; S.Tuse = S.tb[8] < MOE_MAIN_TILES ? S.tb[8] : MOE_MAIN_TILES; S.A = (const char*)(ws + WS_MACT); S.B = (const char*)(ws + WS_MOEDN); S.O = (char*)(ws + WS_ACOMP); S.sparseA = 0;
        S.lda = DFE / 2; S.ldb = DFE / 2; S.ldc = D; S.ocol = 256; S.bstride = (size_t)D * DFE;
        pg8::EpiBf16F8 E{1.0f / (A8_SCALE * W8_SCALE)}; pg8::gemm_phase<pg8::EpiBf16F8, SchedMoe>(F.lds, g, S, E);
        { pg8::Gemm g2{DFE / 2, DFE / 2, DFE / MOE_KCH / 2}; SchedMoeLeft S2; S2.G = F.G; S2.c = F.bid;
#pragma unroll
          for (int q = 0; q < 9; ++q) S2.tb[q] = S.tb[q];
          S2.A = (const char*)(ws + WS_MACT); S2.B = (const char*)(ws + WS_MOEDN); S2.O = (char*)(ws + WS_ACS); S2.bstride = (size_t)D * DFE;
          pg8::EpiPartF32 E2{1.0f / (A8_SCALE * W8_SCALE)}; pg8::gemm_phase<pg8::EpiPartF32, SchedMoeLeft>(F.lds, g2, S2, E2); } } SEAM(16);
    if (IN(17)) { final_phase(F, MOD1, tbv); }
#undef IN
#undef SEAM
}

extern "C" void kernel_launch(void* const* d_in, const int* in_sizes, int n_in, void* d_out, int out_size, void* d_ws, size_t ws_size, hipStream_t stream) {
    static int grid = 0;
    if (grid == 0) {
        if (n_in != 29 || in_sizes[0] != NT * D || out_size != NT * D || ws_size < WS_END) { fprintf(stderr, "kernel_launch: unexpected problem (n_in %d, in0 %d, out %d, ws %zu < %zu); nothing launched\n", n_in, n_in > 0 ? in_sizes[0] : -1, out_size, ws_size, (size_t)WS_END); grid = -1; return; }
        int dev = 0, cus = 0, per_cu = 0;
        if (hipGetDevice(&dev) != hipSuccess || hipDeviceGetAttribute(&cus, hipDeviceAttributeMultiprocessorCount, dev) != hipSuccess) { grid = -1; return; }
        if (hipFuncSetAttribute((const void*)mk_fwd, hipFuncAttributeMaxDynamicSharedMemorySize, LDS_BYTES) != hipSuccess) { fprintf(stderr, "kernel_launch: hipFuncSetAttribute failed\n"); grid = -1; return; }
        if (hipOccupancyMaxActiveBlocksPerMultiprocessor(&per_cu, (const void*)mk_fwd, NTHR, LDS_BYTES) != hipSuccess || per_cu < 1) fprintf(stderr, "kernel_launch: occupancy query reports %d\n", per_cu);
        (void)hipGetLastError();
        grid = cus;
    }
    if (grid < 0) return;
    if (hipMemsetAsync((char*)d_ws + WS_CTL, 0, CTL_ZERO_BYTES, stream) != hipSuccess) return;
    Args a{};
    for (int i = 0; i < 29; ++i) a.in[i] = (const float*)d_in[i];
    a.out = (float*)d_out; a.ws = (unsigned char*)d_ws;
#if MK_PER_PHASE
    for (int ph = 0; ph < NPHASE; ++ph) { a.ph_lo = ph; a.ph_hi = ph + 1; hipLaunchKernelGGL(mk_fwd, dim3(grid), dim3(NTHR), LDS_BYTES, stream, a); }
#else
    a.ph_lo = 0; a.ph_hi = NPHASE; hipLaunchKernelGGL(mk_fwd, dim3(grid), dim3(NTHR), LDS_BYTES, stream, a);
#endif
}
```
